# Optimizing an MI355X kernel written in HIP

```python
import jax, jax.numpy as jnp
from jax import lax
import numpy as np

D_MODEL = 1024
BATCH = 1
SEQ = 16384
DEPTH = 1
DEC_BATCH = 32
DEC_SEQ = 1
PAST_LEN = 16384
PAGE_SIZE = 128

HEAD_DIM_A = 64
HEADS_PER_GROUP_A = 4
DILATED_GROUPS = ((128, 1), (512, 4), (2048, 16))
N_GROUPS_A = len(DILATED_GROUPS)
N_HEADS_A = HEADS_PER_GROUP_A * N_GROUPS_A
WIDTH_A = N_HEADS_A * HEAD_DIM_A
COMB_WIDTH_A = HEADS_PER_GROUP_A * HEAD_DIM_A
CHUNK = 128
N_GROUPS_B = 4
WIDTH_B = 768
GROUP_DIM_B = WIDTH_B // N_GROUPS_B
N_MEM = 256
N_HEADS_M = 4
HEAD_DIM_M = 128
WIDTH_M = N_HEADS_M * HEAD_DIM_M
N_BRANCH = 3
IN_WIDTH = 3 * WIDTH_A + 2 * WIDTH_B + WIDTH_M + N_BRANCH * D_MODEL
D_FF = 2816
CONV_W = 3
LN_EPS = 1e-5
ALPHA = (2.0 * DEPTH) ** 0.25
BETA = (8.0 * DEPTH) ** -0.25
NEG = -1e30

kernel_name = "hybrid_dilated_gmlp_memory_decoder_step"


def layer_norm(x, g, b):
    xf = x.astype(jnp.float32)
    mu = jnp.mean(xf, axis=-1, keepdims=True)
    var = jnp.mean(jnp.square(xf - mu), axis=-1, keepdims=True)
    return ((xf - mu) * lax.rsqrt(var + LN_EPS) * g + b).astype(x.dtype)


def split_in(h):
    bounds = np.cumsum([WIDTH_A, WIDTH_A, WIDTH_A, WIDTH_B, WIDTH_B, WIDTH_M]).tolist()
    return jnp.split(h, bounds, axis=-1)


def heads(t, n_heads, head_dim):
    return t.reshape(t.shape[:-1] + (n_heads, head_dim))


def group_slice(t, g):
    return t[:, :, g * HEADS_PER_GROUP_A:(g + 1) * HEADS_PER_GROUP_A]


def dilated_attn_prompt(q, k, v, window, dilation):
    B, S, H, E = q.shape
    nk = window // dilation
    unit = dilation * nk
    Sp = -(-S // unit) * unit
    nb = Sp // unit
    pad = ((0, 0), (0, Sp - S), (0, 0), (0, 0))

    def to_sub(t):
        return jnp.pad(t, pad).reshape(B, nb, nk, dilation, H, E)

    def with_prev(t):
        prev = jnp.pad(t, ((0, 0), (1, 0), (0, 0), (0, 0), (0, 0), (0, 0)))[:, :-1]
        return jnp.concatenate([prev, t], axis=2)

    qs = to_sub(q)
    kk = with_prev(to_sub(k))
    vv = with_prev(to_sub(v))
    s = jnp.einsum('bnidhe,bnjdhe->bndhij', qs, kk,
                   preferred_element_type=jnp.float32) * (E ** -0.5)
    i = jnp.arange(nk)[:, None]
    j = jnp.arange(2 * nk)[None, :]
    rel = i + nk - j
    blk = jnp.arange(nb)[:, None, None]
    valid = (rel >= 0) & (rel <= nk) & (blk * nk + j - nk >= 0)
    s = jnp.where(valid[None, :, None, None], s, NEG)
    lse = jax.nn.logsumexp(s, axis=-1)
    p = jnp.exp(s - lse[..., None]).astype(v.dtype)
    o = jnp.einsum('bndhij,bnjdhe->bnidhe', p, vv)
    o = o.reshape(B, Sp, H, E)[:, :S]
    lse = lse.transpose(0, 1, 4, 2, 3).reshape(B, Sp, H)[:, :S]
    return o, lse


def dilated_attn_sample(q, k_new, v_new, k_buf, v_buf, window, dilation):
    T, E = q.shape[1], q.shape[-1]
    Wb = k_buf.shape[1]
    nk = window // dilation
    keys = jnp.concatenate([k_buf, k_new], axis=1)
    vals = jnp.concatenate([v_buf, v_new], axis=1)
    i = jnp.arange(T)[:, None]
    kk = jnp.arange(nk + 1)[None, :]
    pos = PAST_LEN + i - kk * dilation
    idx = pos - (PAST_LEN - Wb)
    valid = (pos >= 0) & (idx >= 0)
    idx = jnp.clip(idx, 0, Wb + T - 1)
    kg = jnp.take(keys, idx, axis=1)
    vg = jnp.take(vals, idx, axis=1)
    s = jnp.einsum('bthe,btkhe->bthk', q, kg,
                   preferred_element_type=jnp.float32) * (E ** -0.5)
    s = jnp.where(valid[None, :, None, :], s, NEG)
    lse = jax.nn.logsumexp(s, axis=-1)
    p = jnp.exp(s - lse[..., None]).astype(v_new.dtype)
    o = jnp.einsum('bthk,btkhe->bthe', p, vg)
    return o, lse


def combine_dilations(outs, lses):
    wts = jax.nn.softmax(jnp.stack(lses, axis=0), axis=0)
    o = jnp.einsum('gbsh,gbshe->bshe', wts, jnp.stack(outs, axis=0).astype(jnp.float32))
    B, S = o.shape[:2]
    return o.reshape(B, S, COMB_WIDTH_A).astype(outs[0].dtype)


def gmlp_branch(u, v, ln_g, ln_b, w_s, b_s, rows):
    u = jax.nn.gelu(u)
    v = layer_norm(jax.nn.gelu(v), ln_g, ln_b)
    B, S, W = u.shape
    n = S // rows
    mask = jnp.tril(jnp.ones((rows, rows), dtype=bool))
    ws = jnp.where(mask, w_s[:, :rows, :rows], 0.0).astype(v.dtype)
    vs = v.reshape(B, n, rows, N_GROUPS_B, GROUP_DIM_B)
    mixed = jnp.einsum('gij,bnjgc->bnigc', ws, vs) + b_s[:, :rows].T[:, :, None]
    return u * mixed.reshape(B, S, W), v


def memory_attn(q, mk, mv):
    B, S, H, E = q.shape
    s = jnp.einsum('bshe,bmhe->bshm', q, mk, preferred_element_type=jnp.float32) * (E ** -0.5)
    p = jax.nn.softmax(s, axis=-1).astype(mv.dtype)
    return jnp.einsum('bshm,bmhe->bshe', p, mv).reshape(B, S, WIDTH_M)


def merge_and_ffn(x, o_a, o_b, o_m, gates, conv_state, b_gate, w_ba, w_bb, w_bm, w_out,
                  ln1_g, ln1_b, w_up, conv_w, conv_b, w_down, ln2_g, ln2_b):
    g = jax.nn.sigmoid(gates.reshape(gates.shape[:-1] + (N_BRANCH, D_MODEL)) + b_gate)
    mixed = g[..., 0, :] * (o_a @ w_ba) + g[..., 1, :] * (o_b @ w_bb) + g[..., 2, :] * (o_m @ w_bm)
    x1 = layer_norm(ALPHA * x + mixed @ w_out, ln1_g, ln1_b)
    a, val = jnp.split(x1 @ w_up, 2, axis=-1)
    a_ext = jnp.concatenate([conv_state.astype(a.dtype), a], axis=1)
    S = a.shape[1]
    conv = conv_b + sum(conv_w[k] * a_ext[:, k:k + S] for k in range(CONV_W))
    h = jax.nn.gelu(conv) * val
    y = layer_norm(ALPHA * x1 + h @ w_down, ln2_g, ln2_b)
    return y, a_ext[:, a_ext.shape[1] - (CONV_W - 1):]


def setup_inputs(seed: int = 0) -> dict:
    key = jax.random.key(seed)
    ks = jax.random.split(key, 32)
    f32 = jnp.float32
    nrm = lambda k, shape, scale: jax.random.normal(k, shape, f32) * scale
    win_lens = [min(w, PAST_LEN) for (w, _) in DILATED_GROUPS]
    return {
        "x_prompt": nrm(ks[0], (BATCH, SEQ, D_MODEL), 1.0),
        "x_sample": nrm(ks[1], (DEC_BATCH, DEC_SEQ, D_MODEL), 1.0),
        "mem_prompt": nrm(ks[2], (BATCH, N_MEM, D_MODEL), 1.0),
        "cache_win128_kv": nrm(ks[3], (DEPTH, DEC_BATCH, win_lens[0], 2, HEADS_PER_GROUP_A, HEAD_DIM_A), 1.0),
        "cache_win512_kv": nrm(ks[4], (DEPTH, DEC_BATCH, win_lens[1], 2, HEADS_PER_GROUP_A, HEAD_DIM_A), 1.0),
        "cache_win2048_kv": nrm(ks[5], (DEPTH, DEC_BATCH, win_lens[2], 2, HEADS_PER_GROUP_A, HEAD_DIM_A), 1.0),
        "cache_mem_kv": nrm(ks[6], (DEPTH, DEC_BATCH, N_MEM, 2, N_HEADS_M, HEAD_DIM_M), 1.0),
        "state_ffn_conv": nrm(ks[7], (DEPTH, DEC_BATCH, CONV_W - 1, D_FF), 1.0),
        "w_in": nrm(ks[8], (DEPTH, D_MODEL, IN_WIDTH), D_MODEL ** -0.5),
        "b_gate": nrm(ks[9], (DEPTH, N_BRANCH, D_MODEL), 0.02),
        "ln_v_g": 1.0 + nrm(ks[10], (DEPTH, WIDTH_B), 0.02),
        "ln_v_b": nrm(ks[11], (DEPTH, WIDTH_B), 0.02),
        "w_spatial": nrm(ks[12], (DEPTH, N_GROUPS_B, CHUNK, CHUNK), CHUNK ** -0.5),
        "b_spatial": 1.0 + nrm(ks[13], (DEPTH, N_GROUPS_B, CHUNK), 0.02),
        "w_mem_kv": nrm(ks[14], (DEPTH, D_MODEL, 2 * WIDTH_M), D_MODEL ** -0.5),
        "w_branch_a": nrm(ks[15], (DEPTH, COMB_WIDTH_A, D_MODEL), COMB_WIDTH_A ** -0.5),
        "w_branch_b": nrm(ks[16], (DEPTH, WIDTH_B, D_MODEL), WIDTH_B ** -0.5),
        "w_branch_m": nrm(ks[17], (DEPTH, WIDTH_M, D_MODEL), WIDTH_M ** -0.5),
        "w_out": nrm(ks[18], (DEPTH, D_MODEL, D_MODEL), BETA * D_MODEL ** -0.5),
        "ln1_g": 1.0 + nrm(ks[19], (DEPTH, D_MODEL), 0.02),
        "ln1_b": nrm(ks[20], (DEPTH, D_MODEL), 0.02),
        "w_up": nrm(ks[21], (DEPTH, D_MODEL, 2 * D_FF), D_MODEL ** -0.5),
        "conv_w": nrm(ks[22], (DEPTH, CONV_W, D_FF), CONV_W ** -0.5),
        "conv_b": nrm(ks[23], (DEPTH, D_FF), 0.02),
        "w_down": nrm(ks[24], (DEPTH, D_FF, D_MODEL), BETA * D_FF ** -0.5),
        "ln2_g": 1.0 + nrm(ks[25], (DEPTH, D_MODEL), 0.02),
        "ln2_b": nrm(ks[26], (DEPTH, D_MODEL), 0.02),
    }


def reference(x_prompt, x_sample, mem_prompt, cache_win128_kv, cache_win512_kv, cache_win2048_kv,
              cache_mem_kv, state_ffn_conv, w_in, b_gate, ln_v_g, ln_v_b, w_spatial, b_spatial,
              w_mem_kv, w_branch_a, w_branch_b, w_branch_m, w_out, ln1_g, ln1_b, w_up, conv_w,
              conv_b, w_down, ln2_g, ln2_b):
    win_caches = (cache_win128_kv, cache_win512_kv, cache_win2048_kv)
    yp, ys = x_prompt, x_sample
    win_p = [[] for _ in range(N_GROUPS_A)]
    win_s = [[] for _ in range(N_GROUPS_A)]
    mem_p, conv_p_list, gmlp_s, conv_s_list = [], [], [], []
    for l in range(DEPTH):
        B, S = yp.shape[:2]
        qa, ka, va, ub, vb, qm, gp = split_in(yp @ w_in[l])
        qa, ka, va = (heads(t, N_HEADS_A, HEAD_DIM_A) for t in (qa, ka, va))
        outs, lses = [], []
        for g, (win, dil) in enumerate(DILATED_GROUPS):
            qg, kg, vg = group_slice(qa, g), group_slice(ka, g), group_slice(va, g)
            o, lse = dilated_attn_prompt(qg, kg, vg, win, dil)
            outs.append(o)
            lses.append(lse)
            keep = min(win, S)
            win_p[g].append(jnp.stack([kg[:, S - keep:], vg[:, S - keep:]], axis=2))
        o_a = combine_dilations(outs, lses)
        o_b, _ = gmlp_branch(ub, vb, ln_v_g[l], ln_v_b[l], w_spatial[l], b_spatial[l], CHUNK)
        mkv = (mem_prompt @ w_mem_kv[l]).reshape(B, N_MEM, 2, N_HEADS_M, HEAD_DIM_M)
        mem_p.append(mkv)
        o_m = memory_attn(heads(qm, N_HEADS_M, HEAD_DIM_M), mkv[:, :, 0], mkv[:, :, 1])
        conv0 = jnp.zeros((B, CONV_W - 1, D_FF), yp.dtype)
        yp_next, conv_p = merge_and_ffn(yp, o_a, o_b, o_m, gp, conv0, b_gate[l], w_branch_a[l],
                                        w_branch_b[l], w_branch_m[l], w_out[l], ln1_g[l], ln1_b[l],
                                        w_up[l], conv_w[l], conv_b[l], w_down[l], ln2_g[l], ln2_b[l])
        conv_p_list.append(conv_p)
        T = ys.shape[1]
        qa, ka, va, ub, vb, qm, gs = split_in(ys @ w_in[l])
        qa, ka, va = (heads(t, N_HEADS_A, HEAD_DIM_A) for t in (qa, ka, va))
        outs, lses = [], []
        for g, (win, dil) in enumerate(DILATED_GROUPS):
            qg, kg, vg = group_slice(qa, g), group_slice(ka, g), group_slice(va, g)
            buf = win_caches[g][l]
            o, lse = dilated_attn_sample(qg, kg, vg, buf[:, :, 0], buf[:, :, 1], win, dil)
            outs.append(o)
            lses.append(lse)
            win_s[g].append(jnp.stack([kg, vg], axis=2))
        o_a = combine_dilations(outs, lses)
        o_b, v_rows = gmlp_branch(ub, vb, ln_v_g[l], ln_v_b[l], w_spatial[l], b_spatial[l], T)
        gmlp_s.append(v_rows)
        mkv = cache_mem_kv[l]
        o_m = memory_attn(heads(qm, N_HEADS_M, HEAD_DIM_M), mkv[:, :, 0], mkv[:, :, 1])
        ys_next, conv_s = merge_and_ffn(ys, o_a, o_b, o_m, gs, state_ffn_conv[l], b_gate[l], w_branch_a[l],
                                        w_branch_b[l], w_branch_m[l], w_out[l], ln1_g[l], ln1_b[l],
                                        w_up[l], conv_w[l], conv_b[l], w_down[l], ln2_g[l], ln2_b[l])
        conv_s_list.append(conv_s)
        yp, ys = yp_next, ys_next
    new_win128_kv_prompt = jnp.stack(win_p[0])
    new_win512_kv_prompt = jnp.stack(win_p[1])
    new_win2048_kv_prompt = jnp.stack(win_p[2])
    new_mem_kv_prompt = jnp.stack(mem_p)
    new_ffn_conv_prompt = jnp.stack(conv_p_list)
    new_win128_kv_sample = jnp.stack(win_s[0])
    new_win512_kv_sample = jnp.stack(win_s[1])
    new_win2048_kv_sample = jnp.stack(win_s[2])
    new_gmlp_v_sample = jnp.stack(gmlp_s)
    new_ffn_conv_sample = jnp.stack(conv_s_list)
    return (yp, ys, new_win128_kv_prompt, new_win512_kv_prompt, new_win2048_kv_prompt,
            new_mem_kv_prompt, new_ffn_conv_prompt, new_win128_kv_sample, new_win512_kv_sample,
            new_win2048_kv_sample, new_gmlp_v_sample, new_ffn_conv_sample)
```

```cpp
#include <hip/hip_runtime.h>
#include <hip/hip_cooperative_groups.h>
#include <cstdio>
#include <cstdint>
namespace cg = cooperative_groups;

namespace pg8 {
#define PG8_LAS __attribute__((address_space(3)))
typedef unsigned short bf16_t;
typedef short bf16x8 __attribute__((ext_vector_type(8)));
typedef float f32x4 __attribute__((ext_vector_type(4)));
typedef unsigned u32x4 __attribute__((ext_vector_type(4)));
constexpr int BM = 256, BK = 64, HALF = 128, HTB = HALF * BK * 2  , STAGE_BYTES = 8 * HTB, NXCD = 8, WGM = 8;

__host__ __device__ __forceinline__ int lds_byte(int r, int c) { const int st = (r >> 4) * 2 + (c >> 5), rr = r & 15, cc = c & 31, ob = rr * 64 + cc * 2; return st * 1024 + (ob ^ (((ob >> 9) & 1) << 5)); }
__host__ __device__ __forceinline__ void stage_rc(int b, int& R, int& C) { const int st = b / 1024, sb = b % 1024, swz = sb ^ (((sb >> 9) & 1) << 5); R = (st >> 1) * 16 + swz / 64; C = (st & 1) * 32 + (swz % 64) / 2; }
__host__ __device__ __forceinline__ int perm32(int rho) { const int n = rho >> 4, i = rho & 15; return 8 * (i >> 2) + 4 * n + (i & 3); }

struct Unit { int pm, pn; };
struct Gemm { const bf16_t* A; const bf16_t* Bt; int M, N, K; };

struct StaticOrder {
    int nM, nN, nwg, G, c;
    __host__ __device__ void init(int M, int N, int G_, int c_) { nM = M / BM; nN = N / BM; nwg = nM * nN; G = G_; c = c_; }
    __host__ __device__ bool next(int i, Unit& u) const {
        const long L = (long)i * G + c; if (L >= nwg) return false;
        int wgid = (int)L; { const int q = nwg / NXCD, r = nwg % NXCD, xcd = wgid % NXCD, off = wgid / NXCD; wgid = (xcd < r ? xcd * (q + 1) : r * (q + 1) + (xcd - r) * q) + off; }
        const int nig = WGM * nN, gid = wgid / nig, fm = gid * WGM, gsz = (nM - fm) < WGM ? (nM - fm) : WGM;
        u.pm = fm + ((wgid % nig) % gsz); u.pn = (wgid % nig) / gsz; return true;
    }
    __device__ __forceinline__ void a_ready(const Unit&) const {}
    __device__ __forceinline__ void done(const Unit&) const {}
};
__device__ __forceinline__ unsigned cvt_pk_bf16(float lo, float hi) { unsigned r; asm volatile("v_cvt_pk_bf16_f32 %0, %1, %2" : "=v"(r) : "v"(lo), "v"(hi)); return r; }
__device__ __forceinline__ float bflo(unsigned w) { return __uint_as_float(w << 16); }
__device__ __forceinline__ float bfhi(unsigned w) { return __uint_as_float(w & 0xffff0000u); }
__device__ __forceinline__ float bf2f(bf16_t b) { return __uint_as_float(((unsigned)b) << 16); }
__device__ __forceinline__ bf16_t f2bf(float f) { return (bf16_t)(cvt_pk_bf16(f, 0.f) & 0xffffu); }
__device__ __forceinline__ float gelu_t(float x) { const float u = x * (1.0f + 0.044715f * x * x); return x * __builtin_amdgcn_rcpf(1.0f + __builtin_amdgcn_exp2f(-2.3022082f * u)); }
__device__ __forceinline__ float sigm(float x) { return __builtin_amdgcn_rcpf(1.0f + __builtin_amdgcn_exp2f(-1.44269504f * x)); }

struct EpiBf16P {
    static constexpr bool PERM = true, AFTER_DRAIN = false;
    bf16_t* O; int ldc;
    __device__ __forceinline__ void operator()(const f32x4 (&acc)[2][2][4][2], const Unit& u, int wr, int wc, int fr, int fq) const {
        const int row0 = u.pm * BM + wr * 64 + fr, col0 = u.pn * BM + wc * 32 + 8 * fq;
#pragma unroll
        for (int ai = 0; ai < 2; ++ai)
#pragma unroll
            for (int m = 0; m < 4; ++m) { bf16_t* rowp = O + (size_t)(row0 + ai * HALF + m * 16) * ldc + col0;
#pragma unroll
                for (int bj = 0; bj < 2; ++bj) { const f32x4 v0 = acc[ai][bj][m][0], v1 = acc[ai][bj][m][1];
                    u32x4 w; w.x = cvt_pk_bf16(v0[0], v0[1]); w.y = cvt_pk_bf16(v0[2], v0[3]); w.z = cvt_pk_bf16(v1[0], v1[1]); w.w = cvt_pk_bf16(v1[2], v1[3]);
                    *(u32x4*)(rowp + bj * HALF) = w; } }
    }
};
struct EpiIn {
    static constexpr bool PERM = true, AFTER_DRAIN = false;
    bf16_t* O; int ldc; float* vstat;
    __device__ __forceinline__ void operator()(const f32x4 (&acc)[2][2][4][2], const Unit& u, int wr, int wc, int fr, int fq) const {
        const int mode = (u.pn >= 9 && u.pn < 12) ? 1 : ((u.pn >= 12 && u.pn < 15) ? 2 : 0);
        const int row0 = u.pm * BM + wr * 64 + fr, col0 = u.pn * BM + wc * 32 + 8 * fq;
#pragma unroll
        for (int ai = 0; ai < 2; ++ai)
#pragma unroll
            for (int m = 0; m < 4; ++m) { const int row = row0 + ai * HALF + m * 16; bf16_t* rowp = O + (size_t)row * ldc + col0; float s = 0.f, ss = 0.f;
#pragma unroll
                for (int bj = 0; bj < 2; ++bj) { f32x4 v0 = acc[ai][bj][m][0], v1 = acc[ai][bj][m][1];
                    if (mode) {
#pragma unroll
                        for (int j = 0; j < 4; ++j) { v0[j] = gelu_t(v0[j]); v1[j] = gelu_t(v1[j]); }
                        if (mode == 2) {
#pragma unroll
                            for (int j = 0; j < 4; ++j) { s += v0[j] + v1[j]; ss += v0[j] * v0[j] + v1[j] * v1[j]; } } }
                    u32x4 w; w.x = cvt_pk_bf16(v0[0], v0[1]); w.y = cvt_pk_bf16(v0[2], v0[3]); w.z = cvt_pk_bf16(v1[0], v1[1]); w.w = cvt_pk_bf16(v1[2], v1[3]);
                    *(u32x4*)(rowp + bj * HALF) = w; }
                if (mode == 2) { s += __shfl_xor(s, 16); s += __shfl_xor(s, 32); ss += __shfl_xor(ss, 16); ss += __shfl_xor(ss, 32);
                    if (fq == 0) { __hip_atomic_fetch_add(vstat + 2 * row, s, __ATOMIC_RELAXED, __HIP_MEMORY_SCOPE_AGENT); __hip_atomic_fetch_add(vstat + 2 * row + 1, ss, __ATOMIC_RELAXED, __HIP_MEMORY_SCOPE_AGENT); } } }
    }
};
struct EpiMem {
    static constexpr bool PERM = true, AFTER_DRAIN = false;
    float* F; bf16_t* O;
    __device__ __forceinline__ void operator()(const f32x4 (&acc)[2][2][4][2], const Unit& u, int wr, int wc, int fr, int fq) const {
        const int row0 = u.pm * BM + wr * 64 + fr, col0 = u.pn * BM + wc * 32 + 8 * fq;
#pragma unroll
        for (int ai = 0; ai < 2; ++ai)
#pragma unroll
            for (int m = 0; m < 4; ++m) { const size_t off = (size_t)(row0 + ai * HALF + m * 16) * 1024 + col0;
#pragma unroll
                for (int bj = 0; bj < 2; ++bj) { const f32x4 v0 = acc[ai][bj][m][0], v1 = acc[ai][bj][m][1];
                    *(f32x4*)(F + off + bj * HALF) = v0; *(f32x4*)(F + off + bj * HALF + 4) = v1;
                    u32x4 w; w.x = cvt_pk_bf16(v0[0], v0[1]); w.y = cvt_pk_bf16(v0[2], v0[3]); w.z = cvt_pk_bf16(v1[0], v1[1]); w.w = cvt_pk_bf16(v1[2], v1[3]);
                    *(u32x4*)(O + off + bj * HALF) = w; } }
    }
};
struct EpiGate {
    static constexpr bool PERM = true, AFTER_DRAIN = false;
    const bf16_t* Hg; int ldh; const float* bg; bf16_t* MIX; int first;
    __device__ __forceinline__ void operator()(const f32x4 (&acc)[2][2][4][2], const Unit& u, int wr, int wc, int fr, int fq) const {
        const int row0 = u.pm * BM + wr * 64 + fr, col0 = u.pn * BM + wc * 32 + 8 * fq;
        f32x4 b0[2], b1[2];
#pragma unroll
        for (int bj = 0; bj < 2; ++bj) { b0[bj] = *(const f32x4*)(bg + col0 + bj * HALF); b1[bj] = *(const f32x4*)(bg + col0 + bj * HALF + 4); }
#pragma unroll
        for (int ai = 0; ai < 2; ++ai)
#pragma unroll
            for (int m = 0; m < 4; ++m) { const int row = row0 + ai * HALF + m * 16;
#pragma unroll
                for (int bj = 0; bj < 2; ++bj) { const int col = col0 + bj * HALF;
                    const u32x4 gw = *(const u32x4*)(Hg + (size_t)row * ldh + col);
                    f32x4 v0 = acc[ai][bj][m][0], v1 = acc[ai][bj][m][1];
                    v0[0] *= sigm(bflo(gw.x) + b0[bj][0]); v0[1] *= sigm(bfhi(gw.x) + b0[bj][1]); v0[2] *= sigm(bflo(gw.y) + b0[bj][2]); v0[3] *= sigm(bfhi(gw.y) + b0[bj][3]);
                    v1[0] *= sigm(bflo(gw.z) + b1[bj][0]); v1[1] *= sigm(bfhi(gw.z) + b1[bj][1]); v1[2] *= sigm(bflo(gw.w) + b1[bj][2]); v1[3] *= sigm(bfhi(gw.w) + b1[bj][3]);
                    u32x4* mp = (u32x4*)(MIX + (size_t)row * 1024 + col);
                    if (!first) { const u32x4 ow = *mp; v0[0] += bflo(ow.x); v0[1] += bfhi(ow.x); v0[2] += bflo(ow.y); v0[3] += bfhi(ow.y); v1[0] += bflo(ow.z); v1[1] += bfhi(ow.z); v1[2] += bflo(ow.w); v1[3] += bfhi(ow.w); }
                    u32x4 w; w.x = cvt_pk_bf16(v0[0], v0[1]); w.y = cvt_pk_bf16(v0[2], v0[3]); w.z = cvt_pk_bf16(v1[0], v1[1]); w.w = cvt_pk_bf16(v1[2], v1[3]);
                    *mp = w; }
                asm volatile("" ::: "memory"); }
    }
};
struct EpiRes {
    static constexpr bool PERM = false, AFTER_DRAIN = false;
    const float* res; float* out; float alpha;
    __device__ __forceinline__ void operator()(const f32x4 (&acc)[2][2][4][2], const Unit& u, int wr, int wc, int fr, int fq) const {
        const int row0 = u.pm * BM + wr * 64 + fr, col0 = u.pn * BM + wc * 32 + 4 * fq;
#pragma unroll
        for (int ai = 0; ai < 2; ++ai)
#pragma unroll
            for (int m = 0; m < 4; ++m) { const size_t off = (size_t)(row0 + ai * HALF + m * 16) * 1024 + col0;
#pragma unroll
                for (int bj = 0; bj < 2; ++bj)
#pragma unroll
                    for (int n = 0; n < 2; ++n) { const f32x4 r = *(const f32x4*)(res + off + bj * HALF + n * 16); *(f32x4*)(out + off + bj * HALF + n * 16) = r * alpha + acc[ai][bj][m][n]; }
                if (m & 1) asm volatile("" ::: "memory"); }
    }
};

template <class Epi, class Sched, bool ALIGN_EPI = false, bool SP2 = false>
__device__ __forceinline__ void gemm_phase(PG8_LAS unsigned char* lds, const Gemm g, const Sched& S, const Epi& E) {
    const int tid = threadIdx.x, wid = __builtin_amdgcn_readfirstlane(tid >> 6), lane = tid & 63, wr = wid >> 2, wc = wid & 3, fr = lane & 15, fq = lane >> 4;
    const int K = g.K, nt = K / BK;
    unsigned voffA[2], voffB[2];
#pragma unroll
    for (int i = 0; i < 2; ++i) { int R, C; stage_rc(tid * 16 + i * 8192, R, C); const int Rb = Epi::PERM ? ((R & ~31) + perm32(R & 31)) : R;
        voffA[i] = (unsigned)(R * K + C) * 2u; voffB[i] = (unsigned)(Rb * K + C) * 2u; }
    const size_t kstep = (size_t)(BK * 2);
    const size_t hstep = (size_t)HALF * K * 2;
    const size_t tstep = 2 * hstep;
    const unsigned ldsw = (unsigned)wid * 1024u;
    const int aoff = lds_byte(wr * 64 + fr, fq * 8), boff = lds_byte(wc * 32 + fr, fq * 8);
#define PG8_SA(b, h) (((b) * 2 + (h)) * HTB)
#define PG8_SB(b, h) ((4 + (b) * 2 + (h)) * HTB)
#define PG8_STAGE(bufoff, gbase, voff) do { _Pragma("unroll") for (int _i = 0; _i < 2; ++_i) \
        __builtin_amdgcn_global_load_lds((const unsigned*)((const char*)(gbase) + (voff)[_i]), (PG8_LAS unsigned*)(lds + (bufoff) + ldsw + _i * 8192), 16, 0, 0); } while (0)
#define PG8_LDA(dst, b, h) do { _Pragma("unroll") for (int m = 0; m < 4; ++m) _Pragma("unroll") for (int k = 0; k < 2; ++k) dst[m][k] = *(const PG8_LAS bf16x8*)(lds + PG8_SA(b, h) + aoff + m * 2048 + k * 1024); } while (0)
#define PG8_LDB(dst, b, h) do { _Pragma("unroll") for (int n = 0; n < 2; ++n) _Pragma("unroll") for (int k = 0; k < 2; ++k) dst[n][k] = *(const PG8_LAS bf16x8*)(lds + PG8_SB(b, h) + boff + n * 2048 + k * 1024); } while (0)
#define PG8_MMA(ai, bj, At, Bt) do { __builtin_amdgcn_s_setprio(1); _Pragma("unroll") for (int m = 0; m < 4; ++m) _Pragma("unroll") for (int n = 0; n < 2; ++n) _Pragma("unroll") for (int k = 0; k < 2; ++k) \
        acc[ai][bj][m][n] = __builtin_amdgcn_mfma_f32_16x16x32_bf16(Bt[n][k], At[m][k], acc[ai][bj][m][n], 0, 0, 0); __builtin_amdgcn_s_setprio(0); } while (0)
#define PG8_WAIT_V(n) asm volatile("s_waitcnt vmcnt(" #n ")" ::: "memory")
#define PG8_WAIT_L(n) asm volatile("s_waitcnt lgkmcnt(" #n ")" ::: "memory")
#define PG8_BAR __builtin_amdgcn_s_barrier()
#define PG8_SCHED __builtin_amdgcn_sched_barrier(0)
    Unit cur, nxt; int ui = 0;
    if (!S.next(0, cur)) return;
    f32x4 acc[2][2][4][2];
#pragma unroll
    for (int a = 0; a < 2; ++a)
#pragma unroll
        for (int b = 0; b < 2; ++b)
#pragma unroll
            for (int m = 0; m < 4; ++m)
#pragma unroll
                for (int n = 0; n < 2; ++n) acc[a][b][m][n] = (f32x4){0.f, 0.f, 0.f, 0.f};
    bf16x8 At[4][2], B0[2][2], B1[2][2];
    const char* cA = (const char*)g.A + (size_t)cur.pm * tstep; const char* cB = (const char*)g.Bt + (size_t)cur.pn * tstep;
    S.a_ready(cur);
    if constexpr (SP2) {
        PG8_STAGE(PG8_SB(0, 0), cB, voffB); PG8_STAGE(PG8_SB(0, 1), cB + hstep, voffB); PG8_STAGE(PG8_SA(0, 0), cA, voffA); PG8_STAGE(PG8_SA(0, 1), cA + hstep, voffA);
        if (wr == 1) PG8_BAR;
        PG8_WAIT_V(2); PG8_BAR;
        PG8_STAGE(PG8_SB(1, 0), cB + kstep, voffB); PG8_STAGE(PG8_SA(1, 0), cA + kstep, voffA); PG8_STAGE(PG8_SB(1, 1), cB + hstep + kstep, voffB);
        PG8_WAIT_V(6); PG8_BAR;
    } else {
        PG8_STAGE(PG8_SB(0, 0), cB, voffB); PG8_STAGE(PG8_SA(0, 0), cA, voffA); PG8_STAGE(PG8_SB(0, 1), cB + hstep, voffB); PG8_STAGE(PG8_SA(0, 1), cA + hstep, voffA);
        if (wr == 1) PG8_BAR;
        PG8_WAIT_V(4); PG8_BAR;
        PG8_STAGE(PG8_SB(1, 0), cB + kstep, voffB); PG8_STAGE(PG8_SA(1, 0), cA + kstep, voffA); PG8_STAGE(PG8_SB(1, 1), cB + hstep + kstep, voffB);
        PG8_WAIT_V(6); PG8_BAR;
    }
    for (;;) {
        const bool has_next = S.next(ui + 1, nxt);
        const char* nA = has_next ? (const char*)g.A + (size_t)nxt.pm * tstep : cA; const char* nB = has_next ? (const char*)g.Bt + (size_t)nxt.pn * tstep : cB;
        for (int t = 0; t < nt; t += 2) {
            const bool last = (t == nt - 2);
            const char* a1 = cA + (size_t)(t + 1) * kstep;
            const char* a2 = last ? nA : cA + (size_t)(t + 2) * kstep; const char* b2 = last ? nB : cB + (size_t)(t + 2) * kstep;
            const char* a3 = a2 + kstep; const char* b3 = b2 + kstep;
            if (last && has_next) S.a_ready(nxt);
            if constexpr (SP2) {
            PG8_LDB(B0, 0, 0); PG8_LDB(B1, 0, 1); PG8_SCHED; PG8_LDA(At, 0, 0); PG8_STAGE(PG8_SA(1, 1), a1 + hstep, voffA);
            PG8_WAIT_V(8); PG8_WAIT_L(0); PG8_BAR; PG8_MMA(0, 0, At, B0); PG8_MMA(0, 1, At, B1); PG8_BAR; PG8_SCHED;
            PG8_LDA(At, 0, 1); PG8_STAGE(PG8_SB(0, 0), b2, voffB); PG8_STAGE(PG8_SB(0, 1), b2 + hstep, voffB); PG8_STAGE(PG8_SA(0, 0), a2, voffA);
            PG8_WAIT_V(8); PG8_WAIT_L(0); PG8_BAR; PG8_MMA(1, 0, At, B0); PG8_MMA(1, 1, At, B1); PG8_BAR; PG8_SCHED;
            PG8_LDB(B0, 1, 0); PG8_LDB(B1, 1, 1); PG8_SCHED; PG8_LDA(At, 1, 0); PG8_STAGE(PG8_SA(0, 1), a2 + hstep, voffA);
            PG8_WAIT_V(8); PG8_WAIT_L(0); PG8_BAR; PG8_MMA(0, 0, At, B0); PG8_MMA(0, 1, At, B1); PG8_BAR; PG8_SCHED;
            PG8_LDA(At, 1, 1); PG8_STAGE(PG8_SB(1, 0), b3, voffB); PG8_STAGE(PG8_SB(1, 1), b3 + hstep, voffB); PG8_STAGE(PG8_SA(1, 0), a3, voffA);
            PG8_WAIT_V(8); PG8_WAIT_L(0); PG8_BAR; PG8_MMA(1, 0, At, B0); PG8_MMA(1, 1, At, B1); PG8_BAR; PG8_SCHED;
            } else {
            PG8_LDB(B0, 0, 0); PG8_SCHED; PG8_LDA(At, 0, 0); PG8_STAGE(PG8_SA(1, 1), a1 + hstep, voffA);
            PG8_WAIT_L(8); PG8_BAR; PG8_WAIT_L(0); PG8_MMA(0, 0, At, B0); PG8_BAR; PG8_SCHED;
            PG8_LDB(B1, 0, 1); PG8_STAGE(PG8_SB(0, 0), b2, voffB);
            PG8_BAR; PG8_WAIT_L(0); PG8_MMA(0, 1, At, B1); PG8_BAR;
            PG8_LDA(At, 0, 1); PG8_STAGE(PG8_SA(0, 0), a2, voffA);
            PG8_BAR; PG8_WAIT_L(0); PG8_MMA(1, 0, At, B0); PG8_BAR; PG8_SCHED;
            PG8_STAGE(PG8_SB(0, 1), b2 + hstep, voffB);
            PG8_WAIT_V(6); PG8_BAR; PG8_MMA(1, 1, At, B1); PG8_BAR;
            PG8_LDB(B0, 1, 0); PG8_SCHED; PG8_LDA(At, 1, 0); PG8_STAGE(PG8_SA(0, 1), a2 + hstep, voffA);
            PG8_WAIT_L(8); PG8_BAR; PG8_WAIT_L(0); PG8_MMA(0, 0, At, B0); PG8_BAR; PG8_SCHED;
            PG8_LDB(B1, 1, 1); PG8_STAGE(PG8_SB(1, 0), b3, voffB);
            PG8_BAR; PG8_WAIT_L(0); PG8_MMA(0, 1, At, B1); PG8_BAR;
            PG8_LDA(At, 1, 1); PG8_STAGE(PG8_SA(1, 0), a3, voffA);
            PG8_BAR; PG8_WAIT_L(0); PG8_MMA(1, 0, At, B0); PG8_BAR; PG8_SCHED;
            PG8_STAGE(PG8_SB(1, 1), b3 + hstep, voffB);
            PG8_WAIT_V(6); PG8_BAR; PG8_MMA(1, 1, At, B1); PG8_BAR;
            }
        }
        if constexpr (ALIGN_EPI) { if (wr == 0) PG8_BAR; }
        if constexpr (!Epi::AFTER_DRAIN) { E(acc, cur, wr, wc, fr, fq); S.done(cur); }
        if (!has_next) break;
#pragma unroll
        for (int a = 0; a < 2; ++a)
#pragma unroll
            for (int b = 0; b < 2; ++b)
#pragma unroll
                for (int m = 0; m < 4; ++m)
#pragma unroll
                    for (int n = 0; n < 2; ++n) acc[a][b][m][n] = (f32x4){0.f, 0.f, 0.f, 0.f};
        cur = nxt; cA = nA; cB = nB; ++ui;
        if constexpr (ALIGN_EPI) { if (wr == 1) PG8_BAR; }
    }
    PG8_WAIT_V(0);
    if constexpr (!ALIGN_EPI) { if (wr == 0) PG8_BAR; }
    PG8_BAR;
    if constexpr (Epi::AFTER_DRAIN) { E.fused(acc, cur, wr, wc, fr, fq, lds, wid, lane); S.done(cur); }
#undef PG8_SA
#undef PG8_SB
#undef PG8_STAGE
#undef PG8_LDA
#undef PG8_LDB
#undef PG8_MMA
#undef PG8_WAIT_V
#undef PG8_WAIT_L
#undef PG8_BAR
#undef PG8_SCHED
}
}

using pg8::bf16_t; using pg8::bf16x8; using pg8::f32x4; using pg8::u32x4;
using pg8::cvt_pk_bf16; using pg8::bflo; using pg8::bfhi; using pg8::bf2f; using pg8::f2bf; using pg8::gelu_t; using pg8::sigm;
#define LAS __attribute__((address_space(3)))
typedef unsigned u32x2 __attribute__((ext_vector_type(2)));
typedef float f32x2 __attribute__((ext_vector_type(2)));

constexpr int SQ = 16384, NSMP = 32, MV = SQ + NSMP, DM = 1024, INW = 7424, DFF = 2816, NMEM = 256;
constexpr int C_QA = 0, C_KA = 768, C_VA = 1536, C_UB = 2304, C_VB = 3072, C_QM = 3840, C_GT = 4352;
constexpr float ALPHA = 1.189207115002721f, LN_EPS = 1e-5f;
constexpr size_t O_YP = 0, O_YS = 16777216, O_W128P = 16809984, O_W512P = 16875520, O_W2048P = 17137664, O_MEMP = 18186240, O_CONVP = 18448384,
                 O_W128S = 18454016, O_W512S = 18470400, O_W2048S = 18486784, O_GV = 18503168, O_CONVS = 18527744, O_END = 18707968;
constexpr size_t MiB = 1u << 20;
constexpr size_t WS_VSTAT = 0, WS_WIN = 1 * MiB, WS_WMEM = 16 * MiB, WS_WBA = 18 * MiB, WS_WBB = 19 * MiB, WS_WBM = 21 * MiB, WS_WOUT = 22 * MiB, WS_WUP = 24 * MiB,
                 WS_WDOWN = 35 * MiB, WS_WSB = 41 * MiB, WS_MEMB = 42 * MiB, WS_MKV = 43 * MiB, WS_XB = 44 * MiB, WS_H = 77 * MiB, WS_OG = 313 * MiB, WS_LSE = 338 * MiB,
                 WS_OA = 339 * MiB, WS_OB = 348 * MiB, WS_OM = 373 * MiB, WS_MIX = 390 * MiB, WS_Z1 = 423 * MiB, WS_END = 488 * MiB;
constexpr size_t WS_U = WS_H, WS_HH = WS_OG, WS_X1B = WS_XB;
static_assert(WS_XB + (size_t)MV * DM * 2 <= WS_H && WS_H + (size_t)MV * INW * 2 <= WS_OG && WS_OG + (size_t)3 * MV * 256 * 2 <= WS_LSE && WS_LSE + (size_t)3 * MV * 16 <= WS_OA, "ws map 1");
static_assert(WS_OA + (size_t)MV * 512 <= WS_OB && WS_OB + (size_t)MV * 1536 <= WS_OM && WS_OM + (size_t)MV * 1024 <= WS_MIX && WS_MIX + (size_t)MV * 2048 <= WS_Z1 && WS_Z1 + (size_t)MV * 4096 <= WS_END, "ws map 2");
static_assert(WS_U + (size_t)MV * 2 * DFF * 2 <= WS_OG && WS_HH + (size_t)MV * DFF * 2 <= WS_Z1, "ws map 3");
static_assert(WS_WIN + (size_t)INW * DM * 2 <= WS_WMEM && WS_WUP + (size_t)2 * DFF * DM * 2 <= WS_WDOWN && WS_WDOWN + (size_t)DM * DFF * 2 <= WS_WSB, "ws map 4");
constexpr int LDS_BYTES = 147456;

struct Args { const float* in[27]; float* out; unsigned char* ws; };

__device__ __forceinline__ float wave_sum(float v) {
#pragma unroll
    for (int o = 1; o < 64; o <<= 1) v += __shfl_xor(v, o);
    return v;
}
__device__ __forceinline__ float wave_max(float v) {
#pragma unroll
    for (int o = 1; o < 64; o <<= 1) v = fmaxf(v, __shfl_xor(v, o));
    return v;
}
#define LDS_WAIT() asm volatile("s_waitcnt lgkmcnt(0)" ::: "memory")

__device__ __forceinline__ void p0_transpose_item(const float* W, int K, int N, bf16_t* WT, LAS float* scr, int item, int lane) {
    const int nblk = N / 32, kb = item / nblk, nb = item % nblk, k0 = 64 * kb, n0 = 32 * nb;
#pragma unroll 8
    for (int i = 0; i < 32; ++i) { const int kk = 2 * i + (lane >> 5); scr[kk * 33 + (lane & 31)] = W[(size_t)(k0 + kk) * N + n0 + (lane & 31)]; }
    LDS_WAIT(); asm volatile("" ::: "memory");
    const int c = lane & 7;
#pragma unroll
    for (int j = 0; j < 4; ++j) { const int n = (lane >> 3) + 8 * j; const LAS float* s = scr + (8 * c) * 33 + n;
        u32x4 o; o.x = cvt_pk_bf16(s[0 * 33], s[1 * 33]); o.y = cvt_pk_bf16(s[2 * 33], s[3 * 33]); o.z = cvt_pk_bf16(s[4 * 33], s[5 * 33]); o.w = cvt_pk_bf16(s[6 * 33], s[7 * 33]);
        *(u32x4*)(WT + (size_t)(n0 + n) * K + k0 + 8 * c) = o; }
    LDS_WAIT(); asm volatile("" ::: "memory");
}
__device__ __forceinline__ void cast_bf16(const float* src, bf16_t* dst, size_t n8, size_t gt, size_t GT) {
    for (size_t i = gt; i < n8; i += GT) { const f32x4 a = *(const f32x4*)(src + i * 8), b = *(const f32x4*)(src + i * 8 + 4);
        u32x4 w; w.x = cvt_pk_bf16(a[0], a[1]); w.y = cvt_pk_bf16(a[2], a[3]); w.z = cvt_pk_bf16(b[0], b[1]); w.w = cvt_pk_bf16(b[2], b[3]); *(u32x4*)(dst + i * 8) = w; }
}
__device__ __forceinline__ void p0_prologue(const Args& a, LAS unsigned char* lds, int tid, int wid, int lane) {
    unsigned char* ws = a.ws;
    LAS float* scr = (LAS float*)(lds + wid * 16384);
    const int gw = blockIdx.x * 8 + wid, NGW = gridDim.x * 8;
    const float* Wsrc[8] = {a.in[8], a.in[14], a.in[15], a.in[16], a.in[17], a.in[18], a.in[21], a.in[24]};
    const int Ks[8] = {DM, DM, 256, 768, 512, DM, DM, DFF}, Ns[8] = {INW, 1024, DM, DM, DM, DM, 2 * DFF, DM};
    const size_t Wo[8] = {WS_WIN, WS_WMEM, WS_WBA, WS_WBB, WS_WBM, WS_WOUT, WS_WUP, WS_WDOWN};
    int base = 0;
#pragma unroll
    for (int w = 0; w < 8; ++w) { const int items = (Ks[w] / 64) * (Ns[w] / 32);
        int first = (gw - base % NGW + NGW) % NGW;
        for (int it = first; it < items; it += NGW) p0_transpose_item(Wsrc[w], Ks[w], Ns[w], (bf16_t*)(ws + Wo[w]), scr, it, lane);
        base += items; }
    const size_t gt = (size_t)blockIdx.x * 512 + tid, GT = (size_t)gridDim.x * 512;
    cast_bf16(a.in[0], (bf16_t*)(ws + WS_XB), (size_t)SQ * DM / 8, gt, GT);
    cast_bf16(a.in[1], (bf16_t*)(ws + WS_XB) + (size_t)SQ * DM, (size_t)NSMP * DM / 8, gt, GT);
    cast_bf16(a.in[2], (bf16_t*)(ws + WS_MEMB), (size_t)NMEM * DM / 8, gt, GT);
    { bf16_t* wsb = (bf16_t*)(ws + WS_WSB); const float* wsp = a.in[12];
      for (size_t i = gt; i < 4 * 128 * 128; i += GT) { const int r = (int)(i >> 7) & 127, c = (int)i & 127; wsb[i] = f2bf(c <= r ? wsp[i] : 0.f); } }
    { float* vs = (float*)(ws + WS_VSTAT); for (size_t i = gt; i < (size_t)MV * 2; i += GT) vs[i] = 0.f; }
}

__device__ __forceinline__ float sgemm_item(const bf16_t* A, const bf16_t* Bt, int K, int n0, LAS float* red, int tid, int wid, int lane) {
    const int fr = lane & 15, fq = lane >> 4, kw = K >> 3, nks = kw >> 5;
    const bf16_t* ap = A + (size_t)fr * K + wid * kw + 8 * fq; const bf16_t* bp = Bt + (size_t)(n0 + fr) * K + wid * kw + 8 * fq;
    f32x4 c0 = {0.f, 0.f, 0.f, 0.f}, c1 = {0.f, 0.f, 0.f, 0.f};
    for (int ks = 0; ks < nks; ++ks) { const bf16x8 b = *(const bf16x8*)(bp + 32 * ks), a0 = *(const bf16x8*)(ap + 32 * ks), a1 = *(const bf16x8*)(ap + (size_t)16 * K + 32 * ks);
        c0 = __builtin_amdgcn_mfma_f32_16x16x32_bf16(b, a0, c0, 0, 0, 0); c1 = __builtin_amdgcn_mfma_f32_16x16x32_bf16(b, a1, c1, 0, 0, 0); }
    *(LAS f32x4*)(red + wid * 512 + fr * 16 + 4 * fq) = c0; *(LAS f32x4*)(red + wid * 512 + (16 + fr) * 16 + 4 * fq) = c1;
    __syncthreads();
    float s = 0.f;
#pragma unroll
    for (int w = 0; w < 8; ++w) s += red[w * 512 + tid];
    __syncthreads();
    return s;
}

__device__ __forceinline__ void attn_tile(const bf16_t* H, bf16_t* OG, float* LSE, int T, LAS unsigned char* lds, int tid, int wid, int lane) {
    const int fr = lane & 15, fq = lane >> 4;
    const int g = T >> 9, idx = T & 511, h = idx & 3, rr = idx >> 2, dsh = 2 * g, d = 1 << dsh, n = rr >> dsh, r = rr & (d - 1);
    const int colq = (g * 4 + h) * 64, colk = C_KA + colq, colv = C_VA + colq;
    LAS unsigned char* Ks = lds;
    LAS unsigned char* VT = lds + 36864;
#pragma unroll
    for (int it = 0; it < 4; ++it) { const int p = tid + 512 * it, key = p >> 3, ch = p & 7, kidx = (n - 1) * 128 + key;
        u32x4 v = {0u, 0u, 0u, 0u}; if (kidx >= 0) v = *(const u32x4*)(H + (size_t)(kidx * d + r) * INW + colk + ch * 8);
        *(LAS u32x4*)(Ks + key * 144 + ch * 16) = v; }
#pragma unroll
    for (int it = 0; it < 4; ++it) { const int key = it * 64 + lane, kidx = (n - 1) * 128 + key;
        u32x4 v = {0u, 0u, 0u, 0u}; if (kidx >= 0) v = *(const u32x4*)(H + (size_t)(kidx * d + r) * INW + colv + wid * 8);
        LAS unsigned short* vp = (LAS unsigned short*)(VT + (wid * 8) * 544 + key * 2);
        vp[0 * 272] = (unsigned short)(v.x & 0xffffu); vp[1 * 272] = (unsigned short)(v.x >> 16); vp[2 * 272] = (unsigned short)(v.y & 0xffffu); vp[3 * 272] = (unsigned short)(v.y >> 16);
        vp[4 * 272] = (unsigned short)(v.z & 0xffffu); vp[5 * 272] = (unsigned short)(v.z >> 16); vp[6 * 272] = (unsigned short)(v.w & 0xffffu); vp[7 * 272] = (unsigned short)(v.w >> 16); }
    if (tid < 128) *(LAS u32x4*)(VT + (tid >> 1) * 544 + 512 + (tid & 1) * 16) = (u32x4){0u, 0u, 0u, 0u};
    const int pos = ((n * 128 + 16 * wid + fr) << dsh) + r;
    bf16x8 qf[2];
#pragma unroll
    for (int ks = 0; ks < 2; ++ks) qf[ks] = *(const bf16x8*)(H + (size_t)pos * INW + colq + 8 * fq + 32 * ks);
    __syncthreads();
    f32x4 s[9];
#pragma unroll
    for (int t = 0; t < 9; ++t) { f32x4 acc = {0.f, 0.f, 0.f, 0.f};
#pragma unroll
        for (int ks = 0; ks < 2; ++ks) { const bf16x8 kf = *(const LAS bf16x8*)(Ks + (16 * (wid + t) + fr) * 144 + (8 * fq + 32 * ks) * 2); acc = __builtin_amdgcn_mfma_f32_16x16x32_bf16(kf, qf[ks], acc, 0, 0, 0); }
        s[t] = acc; }
    float mx = -1e30f;
#pragma unroll
    for (int t = 0; t < 9; ++t) { const bool blk_ok = (n > 0) || (wid + t >= 8);
#pragma unroll
        for (int i = 0; i < 4; ++i) { const int jj = 4 * fq + i; bool ok = blk_ok; if (t == 0) ok = ok && (jj >= fr); if (t == 8) ok = ok && (jj <= fr);
            const float v = ok ? s[t][i] : -1e30f; s[t][i] = v; mx = fmaxf(mx, v); } }
    mx = fmaxf(mx, __shfl_xor(mx, 16)); mx = fmaxf(mx, __shfl_xor(mx, 32));
    const float cs = 0.125f * 1.44269504f; float sum = 0.f;
#pragma unroll
    for (int t = 0; t < 9; ++t)
#pragma unroll
        for (int i = 0; i < 4; ++i) { const float p = __builtin_amdgcn_exp2f((s[t][i] - mx) * cs); s[t][i] = p; sum += p; }
    sum += __shfl_xor(sum, 16); sum += __shfl_xor(sum, 32);
    f32x4 o[4];
#pragma unroll
    for (int eb = 0; eb < 4; ++eb) o[eb] = (f32x4){0.f, 0.f, 0.f, 0.f};
#pragma unroll
    for (int c5 = 0; c5 < 5; ++c5) { const int t0 = 2 * c5, t1 = t0 + 1;
        u32x4 pw; pw.x = cvt_pk_bf16(s[t0][0], s[t0][1]); pw.y = cvt_pk_bf16(s[t0][2], s[t0][3]);
        if (t1 < 9) { pw.z = cvt_pk_bf16(s[t1 < 9 ? t1 : 0][0], s[t1 < 9 ? t1 : 0][1]); pw.w = cvt_pk_bf16(s[t1 < 9 ? t1 : 0][2], s[t1 < 9 ? t1 : 0][3]); } else { pw.z = 0u; pw.w = 0u; }
        const bf16x8 pf = __builtin_bit_cast(bf16x8, pw);
#pragma unroll
        for (int eb = 0; eb < 4; ++eb) { const LAS unsigned char* vp = VT + (16 * eb + fr) * 544 + (16 * (wid + t0) + 4 * fq) * 2;
            const u32x2 lo = *(const LAS u32x2*)vp, hi = *(const LAS u32x2*)(vp + 32);
            const u32x4 vw = {lo.x, lo.y, hi.x, hi.y};
            o[eb] = __builtin_amdgcn_mfma_f32_16x16x32_bf16(__builtin_bit_cast(bf16x8, vw), pf, o[eb], 0, 0, 0); } }
    const float inv = 1.0f / sum;
    bf16_t* op = OG + ((size_t)g * MV + pos) * 256 + h * 64 + 4 * fq;
#pragma unroll
    for (int eb = 0; eb < 4; ++eb) { u32x2 w; w.x = cvt_pk_bf16(o[eb][0] * inv, o[eb][1] * inv); w.y = cvt_pk_bf16(o[eb][2] * inv, o[eb][3] * inv); *(u32x2*)(op + 16 * eb) = w; }
    if (fq == 0) LSE[((size_t)g * MV + pos) * 4 + h] = mx * 0.125f + __builtin_amdgcn_logf(sum) * 0.69314718f;
    __syncthreads();
}

__device__ __forceinline__ void sattn_item(const Args& a, const bf16_t* H, bf16_t* OA, int item, LAS float* qs, int lane) {
    const int b = item >> 2, h = item & 3; const size_t row = SQ + b;
    float og[3], lg[3];
#pragma unroll
    for (int g = 0; g < 3; ++g) { const int d = 1 << (2 * g), Wb = 128 * d; const float* cache = a.in[3 + g]; const int colq = (g * 4 + h) * 64;
        const float qe = bf2f(H[row * INW + colq + lane]), kn = bf2f(H[row * INW + C_KA + colq + lane]), vn = bf2f(H[row * INW + C_VA + colq + lane]);
        qs[lane] = qe; LDS_WAIT(); asm volatile("" ::: "memory");
        const float s_new = wave_sum(qe * kn) * 0.125f;
        float sc[2];
#pragma unroll
        for (int hf = 0; hf < 2; ++hf) { const int kk = lane + 1 + 64 * hf, ix = Wb - kk * d; const float* kp = cache + (((size_t)b * Wb + ix) * 2 + 0) * 256 + h * 64; float dot = 0.f;
#pragma unroll
            for (int e = 0; e < 64; e += 4) { const f32x4 k4 = *(const f32x4*)(kp + e); const f32x4 q4 = *(const LAS f32x4*)(qs + e); dot += k4[0] * q4[0] + k4[1] * q4[1] + k4[2] * q4[2] + k4[3] * q4[3]; }
            sc[hf] = dot * 0.125f; }
        const float mx = fmaxf(s_new, wave_max(fmaxf(sc[0], sc[1])));
        const float p0 = __expf(sc[0] - mx), p1 = __expf(sc[1] - mx), pn = __expf(s_new - mx);
        const float sum = wave_sum(p0 + p1) + pn;
        float o = pn * vn;
        for (int kk = 1; kk <= 128; ++kk) { const int ix = Wb - kk * d; const float pk = __shfl(kk <= 64 ? p0 : p1, (kk - 1) & 63);
            o += pk * cache[(((size_t)b * Wb + ix) * 2 + 1) * 256 + h * 64 + lane]; }
        og[g] = o / sum; lg[g] = mx + __logf(sum);
        asm volatile("" ::: "memory"); }
    const float m = fmaxf(lg[0], fmaxf(lg[1], lg[2])); const float w0 = __expf(lg[0] - m), w1 = __expf(lg[1] - m), w2 = __expf(lg[2] - m);
    OA[row * 256 + h * 64 + lane] = f2bf((w0 * og[0] + w1 * og[1] + w2 * og[2]) / (w0 + w1 + w2));
}

__device__ __forceinline__ void mem_load_kv(const bf16_t* MKV, int h, LAS unsigned char* lds, int tid, int wid, int lane) {
    LAS unsigned char* Km = lds;
    LAS unsigned char* VT = lds + 69632;
#pragma unroll
    for (int it = 0; it < 8; ++it) { const int p = tid + 512 * it, key = p >> 4, ch = p & 15;
        *(LAS u32x4*)(Km + key * 272 + ch * 16) = *(const u32x4*)(MKV + (size_t)key * 1024 + h * 128 + ch * 8); }
#pragma unroll
    for (int it = 0; it < 8; ++it) { const int key = (it & 3) * 64 + lane, ch = wid + 8 * (it >> 2);
        const u32x4 v = *(const u32x4*)(MKV + (size_t)key * 1024 + 512 + h * 128 + ch * 8);
        LAS unsigned short* vp = (LAS unsigned short*)(VT + (ch * 8) * 544 + key * 2);
        vp[0 * 272] = (unsigned short)(v.x & 0xffffu); vp[1 * 272] = (unsigned short)(v.x >> 16); vp[2 * 272] = (unsigned short)(v.y & 0xffffu); vp[3 * 272] = (unsigned short)(v.y >> 16);
        vp[4 * 272] = (unsigned short)(v.z & 0xffffu); vp[5 * 272] = (unsigned short)(v.z >> 16); vp[6 * 272] = (unsigned short)(v.w & 0xffffu); vp[7 * 272] = (unsigned short)(v.w >> 16); }
    __syncthreads();
}
__device__ __forceinline__ void mem_tile(const bf16_t* H, bf16_t* OM, int h, int tile, LAS unsigned char* lds, int wid, int lane) {
    const int fr = lane & 15, fq = lane >> 4;
    const LAS unsigned char* Km = lds; const LAS unsigned char* VT = lds + 69632;
    const size_t row = (size_t)tile * 128 + 16 * wid + fr;
    bf16x8 qf[4];
#pragma unroll
    for (int ks = 0; ks < 4; ++ks) qf[ks] = *(const bf16x8*)(H + row * INW + C_QM + h * 128 + 8 * fq + 32 * ks);
    f32x4 s[16];
#pragma unroll
    for (int t = 0; t < 16; ++t) { f32x4 acc = {0.f, 0.f, 0.f, 0.f};
#pragma unroll
        for (int ks = 0; ks < 4; ++ks) { const bf16x8 kf = *(const LAS bf16x8*)(Km + (16 * t + fr) * 272 + (8 * fq + 32 * ks) * 2); acc = __builtin_amdgcn_mfma_f32_16x16x32_bf16(kf, qf[ks], acc, 0, 0, 0); }
        s[t] = acc; }
    float mx = -1e30f;
#pragma unroll
    for (int t = 0; t < 16; ++t)
#pragma unroll
        for (int i = 0; i < 4; ++i) mx = fmaxf(mx, s[t][i]);
    mx = fmaxf(mx, __shfl_xor(mx, 16)); mx = fmaxf(mx, __shfl_xor(mx, 32));
    const float cs = 0.08838834764831845f * 1.44269504f; float sum = 0.f;
#pragma unroll
    for (int t = 0; t < 16; ++t)
#pragma unroll
        for (int i = 0; i < 4; ++i) { const float p = __builtin_amdgcn_exp2f((s[t][i] - mx) * cs); s[t][i] = p; sum += p; }
    sum += __shfl_xor(sum, 16); sum += __shfl_xor(sum, 32);
    f32x4 o[8];
#pragma unroll
    for (int eb = 0; eb < 8; ++eb) o[eb] = (f32x4){0.f, 0.f, 0.f, 0.f};
#pragma unroll
    for (int c = 0; c < 8; ++c) { const int t0 = 2 * c, t1 = t0 + 1;
        u32x4 pw; pw.x = cvt_pk_bf16(s[t0][0], s[t0][1]); pw.y = cvt_pk_bf16(s[t0][2], s[t0][3]); pw.z = cvt_pk_bf16(s[t1][0], s[t1][1]); pw.w = cvt_pk_bf16(s[t1][2], s[t1][3]);
        const bf16x8 pf = __builtin_bit_cast(bf16x8, pw);
#pragma unroll
        for (int eb = 0; eb < 8; ++eb) { const LAS unsigned char* vp = VT + (16 * eb + fr) * 544 + (16 * t0 + 4 * fq) * 2;
            const u32x2 lo = *(const LAS u32x2*)vp, hi = *(const LAS u32x2*)(vp + 32);
            const u32x4 vw = {lo.x, lo.y, hi.x, hi.y};
            o[eb] = __builtin_amdgcn_mfma_f32_16x16x32_bf16(__builtin_bit_cast(bf16x8, vw), pf, o[eb], 0, 0, 0); } }
    const float inv = 1.0f / sum;
    bf16_t* op = OM + row * 512 + h * 128 + 4 * fq;
#pragma unroll
    for (int eb = 0; eb < 8; ++eb) { u32x2 w; w.x = cvt_pk_bf16(o[eb][0] * inv, o[eb][1] * inv); w.y = cvt_pk_bf16(o[eb][2] * inv, o[eb][3] * inv); *(u32x2*)(op + 16 * eb) = w; }
}
__device__ __forceinline__ void smem_item(const Args& a, const bf16_t* H, bf16_t* OM, int item, LAS float* qs, int lane) {
    const int b = item >> 2, h = item & 3; const size_t row = SQ + b; const float* cm = a.in[6];
    { const unsigned qw = *(const unsigned*)(H + row * INW + C_QM + h * 128 + 2 * lane); qs[2 * lane] = bflo(qw); qs[2 * lane + 1] = bfhi(qw); }
    LDS_WAIT(); asm volatile("" ::: "memory");
    float sc[4];
#pragma unroll
    for (int j = 0; j < 4; ++j) { const int k = lane + 64 * j; const float* kp = cm + (((size_t)b * 256 + k) * 2 + 0) * 512 + h * 128; float dot = 0.f;
#pragma unroll 8
        for (int e = 0; e < 128; e += 4) { const f32x4 k4 = *(const f32x4*)(kp + e); const f32x4 q4 = *(const LAS f32x4*)(qs + e); dot += k4[0] * q4[0] + k4[1] * q4[1] + k4[2] * q4[2] + k4[3] * q4[3]; }
        sc[j] = dot * 0.08838834764831845f; }
    const float mx = wave_max(fmaxf(fmaxf(sc[0], sc[1]), fmaxf(sc[2], sc[3])));
    float p[4]; float ps = 0.f;
#pragma unroll
    for (int j = 0; j < 4; ++j) { p[j] = __expf(sc[j] - mx); ps += p[j]; }
    const float sum = wave_sum(ps);
    f32x2 o = {0.f, 0.f};
#pragma unroll
    for (int j = 0; j < 4; ++j)
        for (int kk = 0; kk < 64; ++kk) { const float pk = __shfl(p[j], kk); const int k = kk + 64 * j;
            const f32x2 v = *(const f32x2*)(cm + (((size_t)b * 256 + k) * 2 + 1) * 512 + h * 128 + 2 * lane); o[0] += pk * v[0]; o[1] += pk * v[1]; }
    const float inv = 1.0f / sum;
    *(unsigned*)(OM + row * 512 + h * 128 + 2 * lane) = cvt_pk_bf16(o[0] * inv, o[1] * inv);
    asm volatile("" ::: "memory");
}

__device__ __forceinline__ void gmlp_item(const Args& a, const bf16_t* H, const float* vstat, const bf16_t* WSB, bf16_t* OB, int item, LAS unsigned char* lds, int tid, int wid, int lane) {
    const int fr = lane & 15, fq = lane >> 4, n = item >> 2, g = item & 3, t0 = n * 128;
    LAS unsigned char* VT = lds;
    LAS unsigned char* Wl = lds + 52224;
#pragma unroll
    for (int it = 0; it < 4; ++it) { const int p = tid + 512 * it, i = p >> 4, ch = p & 15;
        *(LAS u32x4*)(Wl + i * 272 + ch * 16) = *(const u32x4*)(WSB + (size_t)g * 16384 + i * 128 + ch * 8); }
    const float* lng = a.in[10]; const float* lnb = a.in[11];
#pragma unroll
    for (int it = 0; it < 6; ++it) { const int j = (it & 1) * 64 + lane, ch = wid + 8 * (it >> 1), c0 = g * 192 + ch * 8;
        const size_t row = (size_t)t0 + j;
        const u32x4 v = *(const u32x4*)(H + row * INW + C_VB + c0);
        const float mean = vstat[2 * row] * (1.0f / 768.0f), var = vstat[2 * row + 1] * (1.0f / 768.0f) - mean * mean, rstd = __builtin_amdgcn_rsqf(var + LN_EPS);
        const f32x4 g0 = *(const f32x4*)(lng + c0), g1 = *(const f32x4*)(lng + c0 + 4), b0 = *(const f32x4*)(lnb + c0), b1 = *(const f32x4*)(lnb + c0 + 4);
        LAS unsigned short* vp = (LAS unsigned short*)(VT + (ch * 8) * 272 + j * 2);
        vp[0 * 136] = f2bf((bflo(v.x) - mean) * rstd * g0[0] + b0[0]); vp[1 * 136] = f2bf((bfhi(v.x) - mean) * rstd * g0[1] + b0[1]);
        vp[2 * 136] = f2bf((bflo(v.y) - mean) * rstd * g0[2] + b0[2]); vp[3 * 136] = f2bf((bfhi(v.y) - mean) * rstd * g0[3] + b0[3]);
        vp[4 * 136] = f2bf((bflo(v.z) - mean) * rstd * g1[0] + b1[0]); vp[5 * 136] = f2bf((bfhi(v.z) - mean) * rstd * g1[1] + b1[1]);
        vp[6 * 136] = f2bf((bflo(v.w) - mean) * rstd * g1[2] + b1[2]); vp[7 * 136] = f2bf((bfhi(v.w) - mean) * rstd * g1[3] + b1[3]); }
    __syncthreads();
    f32x4 acc[12];
#pragma unroll
    for (int cb = 0; cb < 12; ++cb) acc[cb] = (f32x4){0.f, 0.f, 0.f, 0.f};
    const int nks = (wid >> 1) + 1;
    for (int ks = 0; ks < nks; ++ks) { const bf16x8 wf = *(const LAS bf16x8*)(Wl + (16 * wid + fr) * 272 + (8 * fq + 32 * ks) * 2);
#pragma unroll
        for (int cb = 0; cb < 12; ++cb) { const bf16x8 vf = *(const LAS bf16x8*)(VT + (16 * cb + fr) * 272 + (8 * fq + 32 * ks) * 2);
            acc[cb] = __builtin_amdgcn_mfma_f32_16x16x32_bf16(vf, wf, acc[cb], 0, 0, 0); } }
    const size_t row = (size_t)t0 + 16 * wid + fr; const float bsv = a.in[13][g * 128 + 16 * wid + fr];
#pragma unroll
    for (int cb = 0; cb < 12; ++cb) { const int c = g * 192 + 16 * cb + 4 * fq;
        const u32x2 uw = *(const u32x2*)(H + row * INW + C_UB + c);
        u32x2 w; w.x = cvt_pk_bf16(bflo(uw.x) * (acc[cb][0] + bsv), bfhi(uw.x) * (acc[cb][1] + bsv)); w.y = cvt_pk_bf16(bflo(uw.y) * (acc[cb][2] + bsv), bfhi(uw.y) * (acc[cb][3] + bsv));
        *(u32x2*)(OB + row * 768 + c) = w; }
    __syncthreads();
}
__device__ __forceinline__ void sgmlp_item(const Args& a, const bf16_t* H, const float* vstat, bf16_t* OB, int b, int lane) {
    const size_t row = SQ + b; const float* lng = a.in[10]; const float* lnb = a.in[11]; const float* wsp = a.in[12]; const float* bsp = a.in[13];
    const float mean = vstat[2 * row] * (1.0f / 768.0f), var = vstat[2 * row + 1] * (1.0f / 768.0f) - mean * mean, rstd = __builtin_amdgcn_rsqf(var + LN_EPS);
    float* gv = a.out + O_GV + (size_t)b * 768;
#pragma unroll
    for (int jj = 0; jj < 3; ++jj) { const int c = 4 * lane + 256 * jj;
        const u32x2 vw = *(const u32x2*)(H + row * INW + C_VB + c), uw = *(const u32x2*)(H + row * INW + C_UB + c);
        const f32x4 g4 = *(const f32x4*)(lng + c), b4 = *(const f32x4*)(lnb + c);
        f32x4 vn; vn[0] = (bflo(vw.x) - mean) * rstd * g4[0] + b4[0]; vn[1] = (bfhi(vw.x) - mean) * rstd * g4[1] + b4[1]; vn[2] = (bflo(vw.y) - mean) * rstd * g4[2] + b4[2]; vn[3] = (bfhi(vw.y) - mean) * rstd * g4[3] + b4[3];
        *(f32x4*)(gv + c) = vn;
        const int gg = c / 192; const float w00 = wsp[gg * 16384], b00 = bsp[gg * 128];
        u32x2 w; w.x = cvt_pk_bf16(bflo(uw.x) * (w00 * vn[0] + b00), bfhi(uw.x) * (w00 * vn[1] + b00)); w.y = cvt_pk_bf16(bflo(uw.y) * (w00 * vn[2] + b00), bfhi(uw.y) * (w00 * vn[3] + b00));
        *(u32x2*)(OB + row * 768 + c) = w; }
}

__device__ __forceinline__ void ln_row(const float* in, const float* gam, const float* bet, float* out32, bf16_t* out16, int lane) {
    f32x4 v[4]; float s = 0.f;
#pragma unroll
    for (int j = 0; j < 4; ++j) { v[j] = *(const f32x4*)(in + 4 * lane + 256 * j); s += (v[j][0] + v[j][1]) + (v[j][2] + v[j][3]); }
    const float mean = wave_sum(s) * (1.0f / 1024.0f); float s2 = 0.f;
#pragma unroll
    for (int j = 0; j < 4; ++j) { v[j] = v[j] - mean; s2 += (v[j][0] * v[j][0] + v[j][1] * v[j][1]) + (v[j][2] * v[j][2] + v[j][3] * v[j][3]); }
    const float rstd = __builtin_amdgcn_rsqf(wave_sum(s2) * (1.0f / 1024.0f) + LN_EPS);
#pragma unroll
    for (int j = 0; j < 4; ++j) { const f32x4 g4 = *(const f32x4*)(gam + 4 * lane + 256 * j), b4 = *(const f32x4*)(bet + 4 * lane + 256 * j);
        const f32x4 y = v[j] * rstd * g4 + b4;
        *(f32x4*)(out32 + 4 * lane + 256 * j) = y;
        if (out16) { u32x2 w; w.x = cvt_pk_bf16(y[0], y[1]); w.y = cvt_pk_bf16(y[2], y[3]); *(u32x2*)(out16 + 4 * lane + 256 * j) = w; } }
}

__global__ void __launch_bounds__(512, 2) mega(Args a) {
    extern __shared__ __attribute__((aligned(16))) unsigned char lds_raw[];
    cg::grid_group grid = cg::this_grid();
    LAS unsigned char* lds = (LAS unsigned char*)lds_raw;
    const int tid = threadIdx.x, lane = tid & 63, wid = __builtin_amdgcn_readfirstlane(tid >> 6);
    const int bx = blockIdx.x, G = gridDim.x;
    const size_t gt = (size_t)bx * 512 + tid, GT = (size_t)G * 512;
    const int gw = bx * 8 + wid, NGW = G * 8;
    unsigned char* ws = a.ws;
    float* VSTAT = (float*)(ws + WS_VSTAT);
    bf16_t* WinT = (bf16_t*)(ws + WS_WIN); bf16_t* WmemT = (bf16_t*)(ws + WS_WMEM); bf16_t* WbaT = (bf16_t*)(ws + WS_WBA); bf16_t* WbbT = (bf16_t*)(ws + WS_WBB);
    bf16_t* WbmT = (bf16_t*)(ws + WS_WBM); bf16_t* WoutT = (bf16_t*)(ws + WS_WOUT); bf16_t* WupT = (bf16_t*)(ws + WS_WUP); bf16_t* WdownT = (bf16_t*)(ws + WS_WDOWN);
    bf16_t* WSB = (bf16_t*)(ws + WS_WSB); bf16_t* MEMB = (bf16_t*)(ws + WS_MEMB); bf16_t* MKV = (bf16_t*)(ws + WS_MKV);
    bf16_t* XB = (bf16_t*)(ws + WS_XB); bf16_t* H = (bf16_t*)(ws + WS_H); bf16_t* OG = (bf16_t*)(ws + WS_OG); float* LSE = (float*)(ws + WS_LSE);
    bf16_t* OA = (bf16_t*)(ws + WS_OA); bf16_t* OB = (bf16_t*)(ws + WS_OB); bf16_t* OM = (bf16_t*)(ws + WS_OM); bf16_t* MIX = (bf16_t*)(ws + WS_MIX);
    float* Z1 = (float*)(ws + WS_Z1); bf16_t* X1B = (bf16_t*)(ws + WS_X1B); bf16_t* U = (bf16_t*)(ws + WS_U); bf16_t* HH = (bf16_t*)(ws + WS_HH);
    LAS float* red = (LAS float*)lds;

    p0_prologue(a, lds, tid, wid, lane);
    grid.sync();

    for (int it = bx; it < INW / 16; it += G) { const int n0 = it * 16;
        const float v = sgemm_item(XB + (size_t)SQ * DM, WinT, DM, n0, red, tid, wid, lane);
        const int r = tid >> 4, col = n0 + (tid & 15); const size_t row = SQ + r; float o = v;
        if (col >= C_UB && col < C_QM) { o = gelu_t(v); if (col >= C_VB) { __hip_atomic_fetch_add(VSTAT + 2 * row, o, __ATOMIC_RELAXED, __HIP_MEMORY_SCOPE_AGENT); __hip_atomic_fetch_add(VSTAT + 2 * row + 1, o * o, __ATOMIC_RELAXED, __HIP_MEMORY_SCOPE_AGENT); } }
        H[row * INW + col] = f2bf(o); }
    { pg8::Gemm g{XB, WinT, SQ, INW, DM}; pg8::StaticOrder S; S.init(SQ, INW, G, bx);
      pg8::EpiIn E{H, INW, VSTAT};
      pg8::gemm_phase<pg8::EpiIn, pg8::StaticOrder, true, true>(lds, g, S, E); }
    { pg8::Gemm g{MEMB, WmemT, NMEM, 1024, DM}; pg8::StaticOrder S; S.init(NMEM, 1024, G, (bx + 128) % G);
      pg8::EpiMem E{a.out + O_MEMP, MKV};
      pg8::gemm_phase<pg8::EpiMem, pg8::StaticOrder, true, true>(lds, g, S, E); }
    grid.sync();

    for (int T = bx; T < 1536; T += G) attn_tile(H, OG, LSE, T, lds, tid, wid, lane);
    if (wid == 0 && bx < 128) sattn_item(a, H, OA, bx, (LAS float*)lds, lane);
    {
        const size_t oP[3] = {O_W128P, O_W512P, O_W2048P}, oS[3] = {O_W128S, O_W512S, O_W2048S};
#pragma unroll
        for (int g = 0; g < 3; ++g) { const int keep = 128 << (2 * g); float* op = a.out + oP[g]; float* os = a.out + oS[g];
            for (size_t i = gt; i < (size_t)keep * 512; i += GT) { const int p = (int)(i >> 9), kv = (int)(i >> 8) & 1, he = (int)i & 255;
                op[i] = bf2f(H[(size_t)(SQ - keep + p) * INW + (kv ? C_VA : C_KA) + g * 256 + he]); }
            for (size_t i = gt; i < (size_t)NSMP * 512; i += GT) { const int b = (int)(i >> 9), kv = (int)(i >> 8) & 1, he = (int)i & 255;
                os[i] = bf2f(H[(size_t)(SQ + b) * INW + (kv ? C_VA : C_KA) + g * 256 + he]); } }
    }
    grid.sync();

    for (size_t i = gt; i < (size_t)SQ * 32; i += GT) { const size_t tok = i >> 5; const int h = (int)(i >> 3) & 3, e8 = (int)i & 7;
        const float l0 = LSE[(0 * (size_t)MV + tok) * 4 + h], l1 = LSE[(1 * (size_t)MV + tok) * 4 + h], l2 = LSE[(2 * (size_t)MV + tok) * 4 + h];
        const float m = fmaxf(l0, fmaxf(l1, l2)); float w0 = __expf(l0 - m), w1 = __expf(l1 - m), w2 = __expf(l2 - m); const float inv = 1.0f / (w0 + w1 + w2); w0 *= inv; w1 *= inv; w2 *= inv;
        const u32x4 x0 = *(const u32x4*)(OG + (0 * (size_t)MV + tok) * 256 + h * 64 + e8 * 8), x1 = *(const u32x4*)(OG + (1 * (size_t)MV + tok) * 256 + h * 64 + e8 * 8), x2 = *(const u32x4*)(OG + (2 * (size_t)MV + tok) * 256 + h * 64 + e8 * 8);
        u32x4 w;
        w.x = cvt_pk_bf16(w0 * bflo(x0.x) + w1 * bflo(x1.x) + w2 * bflo(x2.x), w0 * bfhi(x0.x) + w1 * bfhi(x1.x) + w2 * bfhi(x2.x));
        w.y = cvt_pk_bf16(w0 * bflo(x0.y) + w1 * bflo(x1.y) + w2 * bflo(x2.y), w0 * bfhi(x0.y) + w1 * bfhi(x1.y) + w2 * bfhi(x2.y));
        w.z = cvt_pk_bf16(w0 * bflo(x0.z) + w1 * bflo(x1.z) + w2 * bflo(x2.z), w0 * bfhi(x0.z) + w1 * bfhi(x1.z) + w2 * bfhi(x2.z));
        w.w = cvt_pk_bf16(w0 * bflo(x0.w) + w1 * bflo(x1.w) + w2 * bflo(x2.w), w0 * bfhi(x0.w) + w1 * bfhi(x1.w) + w2 * bfhi(x2.w));
        *(u32x4*)(OA + tok * 256 + h * 64 + e8 * 8) = w; }
    {
        const int h = bx & 3; mem_load_kv(MKV, h, lds, tid, wid, lane);
        for (int tile = bx >> 2; tile < SQ / 128; tile += (G >> 2)) mem_tile(H, OM, h, tile, lds, wid, lane);
        __syncthreads(); }
    for (int it = bx; it < 512; it += G) gmlp_item(a, H, VSTAT, WSB, OB, it, lds, tid, wid, lane);
    if (wid == 1 && bx < 128) smem_item(a, H, OM, bx, (LAS float*)(lds + 1024), lane);
    if (wid == 2 && bx >= 128 && bx < 160) sgmlp_item(a, H, VSTAT, OB, bx - 128, lane);
    grid.sync();

    for (int it = bx; it < DM / 16; it += G) { const int n0 = it * 16; const int r = tid >> 4, col = n0 + (tid & 15); const size_t row = SQ + r;
        const float va = sgemm_item(OA + (size_t)SQ * 256, WbaT, 256, n0, red, tid, wid, lane);
        const float vb = sgemm_item(OB + (size_t)SQ * 768, WbbT, 768, n0, red, tid, wid, lane);
        const float vm = sgemm_item(OM + (size_t)SQ * 512, WbmT, 512, n0, red, tid, wid, lane);
        const float* bg = a.in[9]; const bf16_t* hg = H + row * INW + C_GT + col;
        const float o = sigm(bf2f(hg[0]) + bg[col]) * va + sigm(bf2f(hg[1024]) + bg[1024 + col]) * vb + sigm(bf2f(hg[2048]) + bg[2048 + col]) * vm;
        MIX[row * 1024 + col] = f2bf(o); }
    { pg8::StaticOrder S; S.init(SQ, DM, G, bx);
      { pg8::Gemm g{OA, WbaT, SQ, DM, 256}; pg8::EpiGate E{H + C_GT, INW, a.in[9], MIX, 1}; pg8::gemm_phase<pg8::EpiGate, pg8::StaticOrder, true, true>(lds, g, S, E); }
      { pg8::Gemm g{OB, WbbT, SQ, DM, 768}; pg8::EpiGate E{H + C_GT + 1024, INW, a.in[9] + 1024, MIX, 0}; pg8::gemm_phase<pg8::EpiGate, pg8::StaticOrder, true, true>(lds, g, S, E); }
      { pg8::Gemm g{OM, WbmT, SQ, DM, 512}; pg8::EpiGate E{H + C_GT + 2048, INW, a.in[9] + 2048, MIX, 0}; pg8::gemm_phase<pg8::EpiGate, pg8::StaticOrder, true, true>(lds, g, S, E); } }
    grid.sync();

    for (int it = bx; it < DM / 16; it += G) { const int n0 = it * 16; const int r = tid >> 4, col = n0 + (tid & 15);
        const float v = sgemm_item(MIX + (size_t)SQ * DM, WoutT, DM, n0, red, tid, wid, lane);
        Z1[(size_t)(SQ + r) * DM + col] = ALPHA * a.in[1][r * DM + col] + v; }
    { pg8::Gemm g{MIX, WoutT, SQ, DM, DM}; pg8::StaticOrder S; S.init(SQ, DM, G, bx);
      pg8::EpiRes E{a.in[0], Z1, ALPHA};
      pg8::gemm_phase<pg8::EpiRes, pg8::StaticOrder, true, true>(lds, g, S, E); }
    grid.sync();

    for (int row = gw; row < MV; row += NGW) ln_row(Z1 + (size_t)row * DM, a.in[19], a.in[20], Z1 + (size_t)row * DM, X1B + (size_t)row * DM, lane);
    grid.sync();

    for (int it = bx; it < 2 * DFF / 16; it += G) { const int n0 = it * 16; const int r = tid >> 4, col = n0 + (tid & 15);
        const float v = sgemm_item(X1B + (size_t)SQ * DM, WupT, DM, n0, red, tid, wid, lane);
        U[(size_t)(SQ + r) * (2 * DFF) + col] = f2bf(v); }
    { pg8::Gemm g{X1B, WupT, SQ, 2 * DFF, DM}; pg8::StaticOrder S; S.init(SQ, 2 * DFF, G, bx);
      pg8::EpiBf16P E{U, 2 * DFF};
      pg8::gemm_phase<pg8::EpiBf16P, pg8::StaticOrder, true, true>(lds, g, S, E); }
    grid.sync();

    { const float* cw = a.in[22]; const float* cb = a.in[23]; const float* st = a.in[7];
      for (size_t i = gt; i < (size_t)MV * (DFF / 8); i += GT) { const size_t row = i / (DFF / 8); const int c = (int)(i % (DFF / 8)) * 8;
        const u32x4 aw = *(const u32x4*)(U + row * (2 * DFF) + c), vw = *(const u32x4*)(U + row * (2 * DFF) + DFF + c);
        float a0[8] = {bflo(aw.x), bfhi(aw.x), bflo(aw.y), bfhi(aw.y), bflo(aw.z), bfhi(aw.z), bflo(aw.w), bfhi(aw.w)};
        float vv[8] = {bflo(vw.x), bfhi(vw.x), bflo(vw.y), bfhi(vw.y), bflo(vw.z), bfhi(vw.z), bflo(vw.w), bfhi(vw.w)};
        float a1[8], a2[8];
        if (row < SQ) {
            u32x4 w1 = {0u, 0u, 0u, 0u}, w2 = {0u, 0u, 0u, 0u};
            if (row >= 1) w1 = *(const u32x4*)(U + (row - 1) * (2 * DFF) + c);
            if (row >= 2) w2 = *(const u32x4*)(U + (row - 2) * (2 * DFF) + c);
            a1[0] = bflo(w1.x); a1[1] = bfhi(w1.x); a1[2] = bflo(w1.y); a1[3] = bfhi(w1.y); a1[4] = bflo(w1.z); a1[5] = bfhi(w1.z); a1[6] = bflo(w1.w); a1[7] = bfhi(w1.w);
            a2[0] = bflo(w2.x); a2[1] = bfhi(w2.x); a2[2] = bflo(w2.y); a2[3] = bfhi(w2.y); a2[4] = bflo(w2.z); a2[5] = bfhi(w2.z); a2[6] = bflo(w2.w); a2[7] = bfhi(w2.w);
            if (row >= SQ - 2) { float* op = a.out + O_CONVP + (row - (SQ - 2)) * DFF + c;
#pragma unroll
                for (int j = 0; j < 8; ++j) op[j] = a0[j]; }
        } else { const size_t b = row - SQ; const float* s0 = st + (b * 2 + 0) * DFF + c; const float* s1 = st + (b * 2 + 1) * DFF + c; float* op = a.out + O_CONVS + b * 2 * DFF + c;
#pragma unroll
            for (int j = 0; j < 8; ++j) { a2[j] = s0[j]; a1[j] = s1[j]; op[j] = s1[j]; op[DFF + j] = a0[j]; } }
        float hv[8];
#pragma unroll
        for (int j = 0; j < 8; ++j) { const float cv = cb[c + j] + cw[c + j] * a2[j] + cw[DFF + c + j] * a1[j] + cw[2 * DFF + c + j] * a0[j]; hv[j] = gelu_t(cv) * vv[j]; }
        u32x4 w; w.x = cvt_pk_bf16(hv[0], hv[1]); w.y = cvt_pk_bf16(hv[2], hv[3]); w.z = cvt_pk_bf16(hv[4], hv[5]); w.w = cvt_pk_bf16(hv[6], hv[7]);
        *(u32x4*)(HH + row * DFF + c) = w; } }
    grid.sync();

    for (int it = bx; it < DM / 16; it += G) { const int n0 = it * 16; const int r = tid >> 4, col = n0 + (tid & 15);
        const float v = sgemm_item(HH + (size_t)SQ * DFF, WdownT, DFF, n0, red, tid, wid, lane);
        float* zp = Z1 + (size_t)(SQ + r) * DM + col; *zp = ALPHA * (*zp) + v; }
    { pg8::Gemm g{HH, WdownT, SQ, DM, DFF}; pg8::StaticOrder S; S.init(SQ, DM, G, bx);
      pg8::EpiRes E{Z1, Z1, ALPHA};
      pg8::gemm_phase<pg8::EpiRes, pg8::StaticOrder, true, true>(lds, g, S, E); }
    grid.sync();

    for (int row = gw; row < MV; row += NGW) ln_row(Z1 + (size_t)row * DM, a.in[25], a.in[26], a.out + (row < SQ ? O_YP + (size_t)row * DM : O_YS + (size_t)(row - SQ) * DM), nullptr, lane);
}

extern "C" void kernel_launch(void* const* d_in, const int* in_sizes, int n_in, void* d_out, int out_size, void* d_ws, size_t ws_size, hipStream_t stream) {
    static int grid = 0;
    if (grid == 0) {
        if (n_in != 27 || (size_t)out_size != O_END || ws_size < WS_END || in_sizes[0] != SQ * DM) { fprintf(stderr, "kernel_launch: unexpected shapes: n_in %d out %d ws %zu\n", n_in, out_size, ws_size); grid = -1; return; }
        int dev = 0, cus = 0, per_cu = 0;
        if (hipGetDevice(&dev) != hipSuccess || hipDeviceGetAttribute(&cus, hipDeviceAttributeMultiprocessorCount, dev) != hipSuccess) { grid = -1; return; }
        if (hipFuncSetAttribute((const void*)mega, hipFuncAttributeMaxDynamicSharedMemorySize, LDS_BYTES) != hipSuccess) { fprintf(stderr, "kernel_launch: hipFuncSetAttribute failed\n"); grid = -1; return; }
        if (hipOccupancyMaxActiveBlocksPerMultiprocessor(&per_cu, (const void*)mega, 512, LDS_BYTES) != hipSuccess || per_cu < 1) { fprintf(stderr, "kernel_launch: occupancy query reports %d blocks per CU\n", per_cu); grid = -1; return; }
        grid = cus;
        if (grid % 4 != 0) grid -= grid % 4;
    }
    if (grid <= 0) return;
    Args a{};
    for (int i = 0; i < 27; ++i) a.in[i] = (const float*)d_in[i];
    a.out = (float*)d_out; a.ws = (unsigned char*)d_ws;
    void* args[] = {&a};
    hipError_t e = hipLaunchCooperativeKernel((const void*)mega, dim3(grid), dim3(512), args, LDS_BYTES, stream);
    if (e != hipSuccess) fprintf(stderr, "kernel_launch: cooperative launch failed: %s (grid %d)\n", hipGetErrorString(e), grid);
}
```

```cpp
#include <hip/hip_runtime.h>
#include <hip/hip_cooperative_groups.h>
#include <cstdio>
#include <cstdint>
namespace cg = cooperative_groups;

namespace pg8 {
#define PG8_LAS __attribute__((address_space(3)))
typedef unsigned short bf16_t;
typedef short bf16x8 __attribute__((ext_vector_type(8)));
typedef float f32x4 __attribute__((ext_vector_type(4)));
typedef unsigned u32x4 __attribute__((ext_vector_type(4)));
constexpr int BM = 256, BK = 64, HALF = 128, HTB = HALF * BK * 2  , STAGE_BYTES = 8 * HTB, NXCD = 8, WGM = 8;

__host__ __device__ __forceinline__ int lds_byte(int r, int c) { const int st = (r >> 4) * 2 + (c >> 5), rr = r & 15, cc = c & 31, ob = rr * 64 + cc * 2; return st * 1024 + (ob ^ (((ob >> 9) & 1) << 5)); }
__host__ __device__ __forceinline__ void stage_rc(int b, int& R, int& C) { const int st = b / 1024, sb = b % 1024, swz = sb ^ (((sb >> 9) & 1) << 5); R = (st >> 1) * 16 + swz / 64; C = (st & 1) * 32 + (swz % 64) / 2; }
__host__ __device__ __forceinline__ int perm32(int rho) { const int n = rho >> 4, i = rho & 15; return 8 * (i >> 2) + 4 * n + (i & 3); }

struct Unit { int pm, pn; };
struct Gemm { const bf16_t* A; const bf16_t* Bt; int M, N, K; };

struct StaticOrder {
    int nM, nN, nwg, G, c;
    __host__ __device__ void init(int M, int N, int G_, int c_) { nM = M / BM; nN = N / BM; nwg = nM * nN; G = G_; c = c_; }
    __host__ __device__ bool next(int i, Unit& u) const {
        const long L = (long)i * G + c; if (L >= nwg) return false;
        int wgid = (int)L; { const int q = nwg / NXCD, r = nwg % NXCD, xcd = wgid % NXCD, off = wgid / NXCD; wgid = (xcd < r ? xcd * (q + 1) : r * (q + 1) + (xcd - r) * q) + off; }
        const int nig = WGM * nN, gid = wgid / nig, fm = gid * WGM, gsz = (nM - fm) < WGM ? (nM - fm) : WGM;
        u.pm = fm + ((wgid % nig) % gsz); u.pn = (wgid % nig) / gsz; return true;
    }
    __device__ __forceinline__ void a_ready(const Unit&) const {}
    __device__ __forceinline__ void done(const Unit&) const {}
};
__device__ __forceinline__ unsigned cvt_pk_bf16(float lo, float hi) { unsigned r; asm volatile("v_cvt_pk_bf16_f32 %0, %1, %2" : "=v"(r) : "v"(lo), "v"(hi)); return r; }
__device__ __forceinline__ float bflo(unsigned w) { return __uint_as_float(w << 16); }
__device__ __forceinline__ float bfhi(unsigned w) { return __uint_as_float(w & 0xffff0000u); }
__device__ __forceinline__ float bf2f(bf16_t b) { return __uint_as_float(((unsigned)b) << 16); }
__device__ __forceinline__ bf16_t f2bf(float f) { return (bf16_t)(cvt_pk_bf16(f, 0.f) & 0xffffu); }
__device__ __forceinline__ float gelu_t(float x) { const float u = x * (1.0f + 0.044715f * x * x); return x * __builtin_amdgcn_rcpf(1.0f + __builtin_amdgcn_exp2f(-2.3022082f * u)); }
__device__ __forceinline__ float sigm(float x) { return __builtin_amdgcn_rcpf(1.0f + __builtin_amdgcn_exp2f(-1.44269504f * x)); }

struct EpiBf16P {
    static constexpr bool PERM = true, AFTER_DRAIN = false;
    bf16_t* O; int ldc;
    __device__ __forceinline__ void operator()(const f32x4 (&acc)[2][2][4][2], const Unit& u, int wr, int wc, int fr, int fq) const {
        const int row0 = u.pm * BM + wr * 64 + fr, col0 = u.pn * BM + wc * 32 + 8 * fq;
#pragma unroll
        for (int ai = 0; ai < 2; ++ai)
#pragma unroll
            for (int m = 0; m < 4; ++m) { bf16_t* rowp = O + (size_t)(row0 + ai * HALF + m * 16) * ldc + col0;
#pragma unroll
                for (int bj = 0; bj < 2; ++bj) { const f32x4 v0 = acc[ai][bj][m][0], v1 = acc[ai][bj][m][1];
                    u32x4 w; w.x = cvt_pk_bf16(v0[0], v0[1]); w.y = cvt_pk_bf16(v0[2], v0[3]); w.z = cvt_pk_bf16(v1[0], v1[1]); w.w = cvt_pk_bf16(v1[2], v1[3]);
                    *(u32x4*)(rowp + bj * HALF) = w; } }
    }
};
struct EpiIn {
    static constexpr bool PERM = true, AFTER_DRAIN = false;
    bf16_t* O; int ldc; float* vstat;
    __device__ __forceinline__ void operator()(const f32x4 (&acc)[2][2][4][2], const Unit& u, int wr, int wc, int fr, int fq) const {
        const int mode = (u.pn >= 9 && u.pn < 12) ? 1 : ((u.pn >= 12 && u.pn < 15) ? 2 : 0);
        const int row0 = u.pm * BM + wr * 64 + fr, col0 = u.pn * BM + wc * 32 + 8 * fq;
#pragma unroll
        for (int ai = 0; ai < 2; ++ai)
#pragma unroll
            for (int m = 0; m < 4; ++m) { const int row = row0 + ai * HALF + m * 16; bf16_t* rowp = O + (size_t)row * ldc + col0; float s = 0.f, ss = 0.f;
#pragma unroll
                for (int bj = 0; bj < 2; ++bj) { f32x4 v0 = acc[ai][bj][m][0], v1 = acc[ai][bj][m][1];
                    if (mode) {
#pragma unroll
                        for (int j = 0; j < 4; ++j) { v0[j] = gelu_t(v0[j]); v1[j] = gelu_t(v1[j]); }
                        if (mode == 2) {
#pragma unroll
                            for (int j = 0; j < 4; ++j) { s += v0[j] + v1[j]; ss += v0[j] * v0[j] + v1[j] * v1[j]; } } }
                    u32x4 w; w.x = cvt_pk_bf16(v0[0], v0[1]); w.y = cvt_pk_bf16(v0[2], v0[3]); w.z = cvt_pk_bf16(v1[0], v1[1]); w.w = cvt_pk_bf16(v1[2], v1[3]);
                    *(u32x4*)(rowp + bj * HALF) = w; }
                if (mode == 2) { s += __shfl_xor(s, 16); s += __shfl_xor(s, 32); ss += __shfl_xor(ss, 16); ss += __shfl_xor(ss, 32);
                    if (fq == 0) { __hip_atomic_fetch_add(vstat + 2 * row, s, __ATOMIC_RELAXED, __HIP_MEMORY_SCOPE_AGENT); __hip_atomic_fetch_add(vstat + 2 * row + 1, ss, __ATOMIC_RELAXED, __HIP_MEMORY_SCOPE_AGENT); } } }
    }
};
struct EpiMem {
    static constexpr bool PERM = true, AFTER_DRAIN = false;
    float* F; bf16_t* O;
    __device__ __forceinline__ void operator()(const f32x4 (&acc)[2][2][4][2], const Unit& u, int wr, int wc, int fr, int fq) const {
        const int row0 = u.pm * BM + wr * 64 + fr, col0 = u.pn * BM + wc * 32 + 8 * fq;
#pragma unroll
        for (int ai = 0; ai < 2; ++ai)
#pragma unroll
            for (int m = 0; m < 4; ++m) { const size_t off = (size_t)(row0 + ai * HALF + m * 16) * 1024 + col0;
#pragma unroll
                for (int bj = 0; bj < 2; ++bj) { const f32x4 v0 = acc[ai][bj][m][0], v1 = acc[ai][bj][m][1];
                    *(f32x4*)(F + off + bj * HALF) = v0; *(f32x4*)(F + off + bj * HALF + 4) = v1;
                    u32x4 w; w.x = cvt_pk_bf16(v0[0], v0[1]); w.y = cvt_pk_bf16(v0[2], v0[3]); w.z = cvt_pk_bf16(v1[0], v1[1]); w.w = cvt_pk_bf16(v1[2], v1[3]);
                    *(u32x4*)(O + off + bj * HALF) = w; } }
    }
};
struct EpiGate {
    static constexpr bool PERM = true, AFTER_DRAIN = false;
    const bf16_t* Hg; int ldh; const float* bg; bf16_t* MIX; int first;
    __device__ __forceinline__ void operator()(const f32x4 (&acc)[2][2][4][2], const Unit& u, int wr, int wc, int fr, int fq) const {
        const int row0 = u.pm * BM + wr * 64 + fr, col0 = u.pn * BM + wc * 32 + 8 * fq;
        f32x4 b0[2], b1[2];
#pragma unroll
        for (int bj = 0; bj < 2; ++bj) { b0[bj] = *(const f32x4*)(bg + col0 + bj * HALF); b1[bj] = *(const f32x4*)(bg + col0 + bj * HALF + 4); }
#pragma unroll
        for (int ai = 0; ai < 2; ++ai)
#pragma unroll
            for (int m = 0; m < 4; ++m) { const int row = row0 + ai * HALF + m * 16;
#pragma unroll
                for (int bj = 0; bj < 2; ++bj) { const int col = col0 + bj * HALF;
                    const u32x4 gw = *(const u32x4*)(Hg + (size_t)row * ldh + col);
                    f32x4 v0 = acc[ai][bj][m][0], v1 = acc[ai][bj][m][1];
                    v0[0] *= sigm(bflo(gw.x) + b0[bj][0]); v0[1] *= sigm(bfhi(gw.x) + b0[bj][1]); v0[2] *= sigm(bflo(gw.y) + b0[bj][2]); v0[3] *= sigm(bfhi(gw.y) + b0[bj][3]);
                    v1[0] *= sigm(bflo(gw.z) + b1[bj][0]); v1[1] *= sigm(bfhi(gw.z) + b1[bj][1]); v1[2] *= sigm(bflo(gw.w) + b1[bj][2]); v1[3] *= sigm(bfhi(gw.w) + b1[bj][3]);
                    u32x4* mp = (u32x4*)(MIX + (size_t)row * 1024 + col);
                    if (!first) { const u32x4 ow = *mp; v0[0] += bflo(ow.x); v0[1] += bfhi(ow.x); v0[2] += bflo(ow.y); v0[3] += bfhi(ow.y); v1[0] += bflo(ow.z); v1[1] += bfhi(ow.z); v1[2] += bflo(ow.w); v1[3] += bfhi(ow.w); }
                    u32x4 w; w.x = cvt_pk_bf16(v0[0], v0[1]); w.y = cvt_pk_bf16(v0[2], v0[3]); w.z = cvt_pk_bf16(v1[0], v1[1]); w.w = cvt_pk_bf16(v1[2], v1[3]);
                    *mp = w; }
                asm volatile("" ::: "memory"); }
    }
};
struct EpiRes {
    static constexpr bool PERM = false, AFTER_DRAIN = false;
    const float* res; float* out; float alpha;
    __device__ __forceinline__ void operator()(const f32x4 (&acc)[2][2][4][2], const Unit& u, int wr, int wc, int fr, int fq) const {
        const int row0 = u.pm * BM + wr * 64 + fr, col0 = u.pn * BM + wc * 32 + 4 * fq;
#pragma unroll
        for (int ai = 0; ai < 2; ++ai)
#pragma unroll
            for (int m = 0; m < 4; ++m) { const size_t off = (size_t)(row0 + ai * HALF + m * 16) * 1024 + col0;
#pragma unroll
                for (int bj = 0; bj < 2; ++bj)
#pragma unroll
                    for (int n = 0; n < 2; ++n) { const f32x4 r = *(const f32x4*)(res + off + bj * HALF + n * 16); *(f32x4*)(out + off + bj * HALF + n * 16) = r * alpha + acc[ai][bj][m][n]; }
                if (m & 1) asm volatile("" ::: "memory"); }
    }
};

template <class Epi, class Sched, bool ALIGN_EPI = false, bool SP2 = false>
__device__ __forceinline__ void gemm_phase(PG8_LAS unsigned char* lds, const Gemm g, const Sched& S, const Epi& E) {
    const int tid = threadIdx.x, wid = __builtin_amdgcn_readfirstlane(tid >> 6), lane = tid & 63, wr = wid >> 2, wc = wid & 3, fr = lane & 15, fq = lane >> 4;
    const int K = g.K, nt = K / BK;
    unsigned voffA[2], voffB[2];
#pragma unroll
    for (int i = 0; i < 2; ++i) { int R, C; stage_rc(tid * 16 + i * 8192, R, C); const int Rb = Epi::PERM ? ((R & ~31) + perm32(R & 31)) : R;
        voffA[i] = (unsigned)(R * K + C) * 2u; voffB[i] = (unsigned)(Rb * K + C) * 2u; }
    const size_t kstep = (size_t)(BK * 2);
    const size_t hstep = (size_t)HALF * K * 2;
    const size_t tstep = 2 * hstep;
    const unsigned ldsw = (unsigned)wid * 1024u;
    const int aoff = lds_byte(wr * 64 + fr, fq * 8), boff = lds_byte(wc * 32 + fr, fq * 8);
#define PG8_SA(b, h) (((b) * 2 + (h)) * HTB)
#define PG8_SB(b, h) ((4 + (b) * 2 + (h)) * HTB)
#define PG8_STAGE(bufoff, gbase, voff) do { _Pragma("unroll") for (int _i = 0; _i < 2; ++_i) \
        __builtin_amdgcn_global_load_lds((const unsigned*)((const char*)(gbase) + (voff)[_i]), (PG8_LAS unsigned*)(lds + (bufoff) + ldsw + _i * 8192), 16, 0, 0); } while (0)
#define PG8_LDA(dst, b, h) do { _Pragma("unroll") for (int m = 0; m < 4; ++m) _Pragma("unroll") for (int k = 0; k < 2; ++k) dst[m][k] = *(const PG8_LAS bf16x8*)(lds + PG8_SA(b, h) + aoff + m * 2048 + k * 1024); } while (0)
#define PG8_LDB(dst, b, h) do { _Pragma("unroll") for (int n = 0; n < 2; ++n) _Pragma("unroll") for (int k = 0; k < 2; ++k) dst[n][k] = *(const PG8_LAS bf16x8*)(lds + PG8_SB(b, h) + boff + n * 2048 + k * 1024); } while (0)
#define PG8_MMA(ai, bj, At, Bt) do { __builtin_amdgcn_s_setprio(1); _Pragma("unroll") for (int m = 0; m < 4; ++m) _Pragma("unroll") for (int n = 0; n < 2; ++n) _Pragma("unroll") for (int k = 0; k < 2; ++k) \
        acc[ai][bj][m][n] = __builtin_amdgcn_mfma_f32_16x16x32_bf16(Bt[n][k], At[m][k], acc[ai][bj][m][n], 0, 0, 0); __builtin_amdgcn_s_setprio(0); } while (0)
#define PG8_WAIT_V(n) asm volatile("s_waitcnt vmcnt(" #n ")" ::: "memory")
#define PG8_WAIT_L(n) asm volatile("s_waitcnt lgkmcnt(" #n ")" ::: "memory")
#define PG8_BAR __builtin_amdgcn_s_barrier()
#define PG8_SCHED __builtin_amdgcn_sched_barrier(0)
    Unit cur, nxt; int ui = 0;
    if (!S.next(0, cur)) return;
    f32x4 acc[2][2][4][2];
#pragma unroll
    for (int a = 0; a < 2; ++a)
#pragma unroll
        for (int b = 0; b < 2; ++b)
#pragma unroll
            for (int m = 0; m < 4; ++m)
#pragma unroll
                for (int n = 0; n < 2; ++n) acc[a][b][m][n] = (f32x4){0.f, 0.f, 0.f, 0.f};
    bf16x8 At[4][2], B0[2][2], B1[2][2];
    const char* cA = (const char*)g.A + (size_t)cur.pm * tstep; const char* cB = (const char*)g.Bt + (size_t)cur.pn * tstep;
    S.a_ready(cur);
    if constexpr (SP2) {
        PG8_STAGE(PG8_SB(0, 0), cB, voffB); PG8_STAGE(PG8_SB(0, 1), cB + hstep, voffB); PG8_STAGE(PG8_SA(0, 0), cA, voffA); PG8_STAGE(PG8_SA(0, 1), cA + hstep, voffA);
        if (wr == 1) PG8_BAR;
        PG8_WAIT_V(2); PG8_BAR;
        PG8_STAGE(PG8_SB(1, 0), cB + kstep, voffB); PG8_STAGE(PG8_SA(1, 0), cA + kstep, voffA); PG8_STAGE(PG8_SB(1, 1), cB + hstep + kstep, voffB);
        PG8_WAIT_V(6); PG8_BAR;
    } else {
        PG8_STAGE(PG8_SB(0, 0), cB, voffB); PG8_STAGE(PG8_SA(0, 0), cA, voffA); PG8_STAGE(PG8_SB(0, 1), cB + hstep, voffB); PG8_STAGE(PG8_SA(0, 1), cA + hstep, voffA);
        if (wr == 1) PG8_BAR;
        PG8_WAIT_V(4); PG8_BAR;
        PG8_STAGE(PG8_SB(1, 0), cB + kstep, voffB); PG8_STAGE(PG8_SA(1, 0), cA + kstep, voffA); PG8_STAGE(PG8_SB(1, 1), cB + hstep + kstep, voffB);
        PG8_WAIT_V(6); PG8_BAR;
    }
    for (;;) {
        const bool has_next = S.next(ui + 1, nxt);
        const char* nA = has_next ? (const char*)g.A + (size_t)nxt.pm * tstep : cA; const char* nB = has_next ? (const char*)g.Bt + (size_t)nxt.pn * tstep : cB;
        for (int t = 0; t < nt; t += 2) {
            const bool last = (t == nt - 2);
            const char* a1 = cA + (size_t)(t + 1) * kstep;
            const char* a2 = last ? nA : cA + (size_t)(t + 2) * kstep; const char* b2 = last ? nB : cB + (size_t)(t + 2) * kstep;
            const char* a3 = a2 + kstep; const char* b3 = b2 + kstep;
            if (last && has_next) S.a_ready(nxt);
            if constexpr (SP2) {
            PG8_LDB(B0, 0, 0); PG8_LDB(B1, 0, 1); PG8_SCHED; PG8_LDA(At, 0, 0); PG8_STAGE(PG8_SA(1, 1), a1 + hstep, voffA);
            PG8_WAIT_V(8); PG8_WAIT_L(0); PG8_BAR; PG8_MMA(0, 0, At, B0); PG8_MMA(0, 1, At, B1); PG8_BAR; PG8_SCHED;
            PG8_LDA(At, 0, 1); PG8_STAGE(PG8_SB(0, 0), b2, voffB); PG8_STAGE(PG8_SB(0, 1), b2 + hstep, voffB); PG8_STAGE(PG8_SA(0, 0), a2, voffA);
            PG8_WAIT_V(8); PG8_WAIT_L(0); PG8_BAR; PG8_MMA(1, 0, At, B0); PG8_MMA(1, 1, At, B1); PG8_BAR; PG8_SCHED;
            PG8_LDB(B0, 1, 0); PG8_LDB(B1, 1, 1); PG8_SCHED; PG8_LDA(At, 1, 0); PG8_STAGE(PG8_SA(0, 1), a2 + hstep, voffA);
            PG8_WAIT_V(8); PG8_WAIT_L(0); PG8_BAR; PG8_MMA(0, 0, At, B0); PG8_MMA(0, 1, At, B1); PG8_BAR; PG8_SCHED;
            PG8_LDA(At, 1, 1); PG8_STAGE(PG8_SB(1, 0), b3, voffB); PG8_STAGE(PG8_SB(1, 1), b3 + hstep, voffB); PG8_STAGE(PG8_SA(1, 0), a3, voffA);
            PG8_WAIT_V(8); PG8_WAIT_L(0); PG8_BAR; PG8_MMA(1, 0, At, B0); PG8_MMA(1, 1, At, B1); PG8_BAR; PG8_SCHED;
            } else {
            PG8_LDB(B0, 0, 0); PG8_SCHED; PG8_LDA(At, 0, 0); PG8_STAGE(PG8_SA(1, 1), a1 + hstep, voffA);
            PG8_WAIT_L(8); PG8_BAR; PG8_WAIT_L(0); PG8_MMA(0, 0, At, B0); PG8_BAR; PG8_SCHED;
            PG8_LDB(B1, 0, 1); PG8_STAGE(PG8_SB(0, 0), b2, voffB);
            PG8_BAR; PG8_WAIT_L(0); PG8_MMA(0, 1, At, B1); PG8_BAR;
            PG8_LDA(At, 0, 1); PG8_STAGE(PG8_SA(0, 0), a2, voffA);
            PG8_BAR; PG8_WAIT_L(0); PG8_MMA(1, 0, At, B0); PG8_BAR; PG8_SCHED;
            PG8_STAGE(PG8_SB(0, 1), b2 + hstep, voffB);
            PG8_WAIT_V(6); PG8_BAR; PG8_MMA(1, 1, At, B1); PG8_BAR;
            PG8_LDB(B0, 1, 0); PG8_SCHED; PG8_LDA(At, 1, 0); PG8_STAGE(PG8_SA(0, 1), a2 + hstep, voffA);
            PG8_WAIT_L(8); PG8_BAR; PG8_WAIT_L(0); PG8_MMA(0, 0, At, B0); PG8_BAR; PG8_SCHED;
            PG8_LDB(B1, 1, 1); PG8_STAGE(PG8_SB(1, 0), b3, voffB);
            PG8_BAR; PG8_WAIT_L(0); PG8_MMA(0, 1, At, B1); PG8_BAR;
            PG8_LDA(At, 1, 1); PG8_STAGE(PG8_SA(1, 0), a3, voffA);
            PG8_BAR; PG8_WAIT_L(0); PG8_MMA(1, 0, At, B0); PG8_BAR; PG8_SCHED;
            PG8_STAGE(PG8_SB(1, 1), b3 + hstep, voffB);
            PG8_WAIT_V(6); PG8_BAR; PG8_MMA(1, 1, At, B1); PG8_BAR;
            }
        }
        if constexpr (ALIGN_EPI) { if (wr == 0) PG8_BAR; }
        if constexpr (!Epi::AFTER_DRAIN) { E(acc, cur, wr, wc, fr, fq); S.done(cur); }
        if (!has_next) break;
#pragma unroll
        for (int a = 0; a < 2; ++a)
#pragma unroll
            for (int b = 0; b < 2; ++b)
#pragma unroll
                for (int m = 0; m < 4; ++m)
#pragma unroll
                    for (int n = 0; n < 2; ++n) acc[a][b][m][n] = (f32x4){0.f, 0.f, 0.f, 0.f};
        cur = nxt; cA = nA; cB = nB; ++ui;
        if constexpr (ALIGN_EPI) { if (wr == 1) PG8_BAR; }
    }
    PG8_WAIT_V(0);
    if constexpr (!ALIGN_EPI) { if (wr == 0) PG8_BAR; }
    PG8_BAR;
    if constexpr (Epi::AFTER_DRAIN) { E.fused(acc, cur, wr, wc, fr, fq, lds, wid, lane); S.done(cur); }
#undef PG8_SA
#undef PG8_SB
#undef PG8_STAGE
#undef PG8_LDA
#undef PG8_LDB
#undef PG8_MMA
#undef PG8_WAIT_V
#undef PG8_WAIT_L
#undef PG8_BAR
#undef PG8_SCHED
}
}

using pg8::bf16_t; using pg8::bf16x8; using pg8::f32x4; using pg8::u32x4;
using pg8::cvt_pk_bf16; using pg8::bflo; using pg8::bfhi; using pg8::bf2f; using pg8::f2bf; using pg8::gelu_t; using pg8::sigm;
#define LAS __attribute__((address_space(3)))
typedef unsigned u32x2 __attribute__((ext_vector_type(2)));
typedef float f32x2 __attribute__((ext_vector_type(2)));

constexpr int SQ = 16384, NSMP = 32, MV = SQ + NSMP, DM = 1024, INW = 7424, DFF = 2816, NMEM = 256;
constexpr int C_QA = 0, C_KA = 768, C_VA = 1536, C_UB = 2304, C_VB = 3072, C_QM = 3840, C_GT = 4352;
constexpr float ALPHA = 1.189207115002721f, LN_EPS = 1e-5f;
constexpr size_t O_YP = 0, O_YS = 16777216, O_W128P = 16809984, O_W512P = 16875520, O_W2048P = 17137664, O_MEMP = 18186240, O_CONVP = 18448384,
                 O_W128S = 18454016, O_W512S = 18470400, O_W2048S = 18486784, O_GV = 18503168, O_CONVS = 18527744, O_END = 18707968;
constexpr size_t MiB = 1u << 20;
constexpr size_t WS_BAR = 512 * 1024;
constexpr size_t WS_VSTAT = 0, WS_WIN = 1 * MiB, WS_WMEM = 16 * MiB, WS_WBA = 18 * MiB, WS_WBB = 19 * MiB, WS_WBM = 21 * MiB, WS_WOUT = 22 * MiB, WS_WUP = 24 * MiB,
                 WS_WDOWN = 35 * MiB, WS_WSB = 41 * MiB, WS_MEMB = 42 * MiB, WS_MKV = 43 * MiB, WS_XB = 44 * MiB, WS_H = 77 * MiB, WS_OG = 313 * MiB, WS_LSE = 338 * MiB,
                 WS_OA = 339 * MiB, WS_OB = 348 * MiB, WS_OM = 373 * MiB, WS_MIX = 390 * MiB, WS_Z1 = 423 * MiB, WS_END = 488 * MiB;
constexpr size_t WS_U = WS_H, WS_HH = WS_OG, WS_X1B = WS_XB;
static_assert(WS_XB + (size_t)MV * DM * 2 <= WS_H && WS_H + (size_t)MV * INW * 2 <= WS_OG && WS_OG + (size_t)3 * MV * 256 * 2 <= WS_LSE && WS_LSE + (size_t)3 * MV * 16 <= WS_OA, "ws map 1");
static_assert(WS_OA + (size_t)MV * 512 <= WS_OB && WS_OB + (size_t)MV * 1536 <= WS_OM && WS_OM + (size_t)MV * 1024 <= WS_MIX && WS_MIX + (size_t)MV * 2048 <= WS_Z1 && WS_Z1 + (size_t)MV * 4096 <= WS_END, "ws map 2");
static_assert(WS_U + (size_t)MV * 2 * DFF * 2 <= WS_OG && WS_HH + (size_t)MV * DFF * 2 <= WS_Z1, "ws map 3");
static_assert(WS_WIN + (size_t)INW * DM * 2 <= WS_WMEM && WS_WUP + (size_t)2 * DFF * DM * 2 <= WS_WDOWN && WS_WDOWN + (size_t)DM * DFF * 2 <= WS_WSB, "ws map 4");
constexpr int LDS_BYTES = 147456;

struct Args { const float* in[27]; float* out; unsigned char* ws; };

__device__ __forceinline__ float wave_sum(float v) {
#pragma unroll
    for (int o = 1; o < 64; o <<= 1) v += __shfl_xor(v, o);
    return v;
}
__device__ __forceinline__ float wave_max(float v) {
#pragma unroll
    for (int o = 1; o < 64; o <<= 1) v = fmaxf(v, __shfl_xor(v, o));
    return v;
}
#define LDS_WAIT() asm volatile("s_waitcnt lgkmcnt(0)" ::: "memory")

__device__ __forceinline__ void p0_transpose_item(const float* W, int K, int N, bf16_t* WT, LAS float* scr, int item, int lane) {
    const int nblk = N / 32, kb = item / nblk, nb = item % nblk, k0 = 64 * kb, n0 = 32 * nb;
#pragma unroll 8
    for (int i = 0; i < 32; ++i) { const int kk = 2 * i + (lane >> 5); scr[kk * 33 + (lane & 31)] = W[(size_t)(k0 + kk) * N + n0 + (lane & 31)]; }
    LDS_WAIT(); asm volatile("" ::: "memory");
    const int c = lane & 7;
#pragma unroll
    for (int j = 0; j < 4; ++j) { const int n = (lane >> 3) + 8 * j; const LAS float* s = scr + (8 * c) * 33 + n;
        u32x4 o; o.x = cvt_pk_bf16(s[0 * 33], s[1 * 33]); o.y = cvt_pk_bf16(s[2 * 33], s[3 * 33]); o.z = cvt_pk_bf16(s[4 * 33], s[5 * 33]); o.w = cvt_pk_bf16(s[6 * 33], s[7 * 33]);
        *(u32x4*)(WT + (size_t)(n0 + n) * K + k0 + 8 * c) = o; }
    LDS_WAIT(); asm volatile("" ::: "memory");
}
__device__ __forceinline__ void cast_bf16(const float* src, bf16_t* dst, size_t n8, size_t gt, size_t GT) {
    for (size_t i = gt; i < n8; i += GT) { const f32x4 a = *(const f32x4*)(src + i * 8), b = *(const f32x4*)(src + i * 8 + 4);
        u32x4 w; w.x = cvt_pk_bf16(a[0], a[1]); w.y = cvt_pk_bf16(a[2], a[3]); w.z = cvt_pk_bf16(b[0], b[1]); w.w = cvt_pk_bf16(b[2], b[3]); *(u32x4*)(dst + i * 8) = w; }
}
__device__ __forceinline__ void p0_prologue(const Args& a, LAS unsigned char* lds, int tid, int wid, int lane) {
    unsigned char* ws = a.ws;
    LAS float* scr = (LAS float*)(lds + wid * 16384);
    const int gw = blockIdx.x * 8 + wid, NGW = gridDim.x * 8;
    const float* Wsrc[8] = {a.in[8], a.in[14], a.in[15], a.in[16], a.in[17], a.in[18], a.in[21], a.in[24]};
    const int Ks[8] = {DM, DM, 256, 768, 512, DM, DM, DFF}, Ns[8] = {INW, 1024, DM, DM, DM, DM, 2 * DFF, DM};
    const size_t Wo[8] = {WS_WIN, WS_WMEM, WS_WBA, WS_WBB, WS_WBM, WS_WOUT, WS_WUP, WS_WDOWN};
    int base = 0;
#pragma unroll
    for (int w = 0; w < 8; ++w) { const int items = (Ks[w] / 64) * (Ns[w] / 32);
        int first = (gw - base % NGW + NGW) % NGW;
        for (int it = first; it < items; it += NGW) p0_transpose_item(Wsrc[w], Ks[w], Ns[w], (bf16_t*)(ws + Wo[w]), scr, it, lane);
        base += items; }
    const size_t gt = (size_t)blockIdx.x * 512 + tid, GT = (size_t)gridDim.x * 512;
    cast_bf16(a.in[0], (bf16_t*)(ws + WS_XB), (size_t)SQ * DM / 8, gt, GT);
    cast_bf16(a.in[1], (bf16_t*)(ws + WS_XB) + (size_t)SQ * DM, (size_t)NSMP * DM / 8, gt, GT);
    cast_bf16(a.in[2], (bf16_t*)(ws + WS_MEMB), (size_t)NMEM * DM / 8, gt, GT);
    { bf16_t* wsb = (bf16_t*)(ws + WS_WSB); const float* wsp = a.in[12];
      for (size_t i = gt; i < 4 * 128 * 128; i += GT) { const int r = (int)(i >> 7) & 127, c = (int)i & 127; wsb[i] = f2bf(c <= r ? wsp[i] : 0.f); } }
    { float* vs = (float*)(ws + WS_VSTAT); for (size_t i = gt; i < (size_t)MV * 2; i += GT) vs[i] = 0.f; }
}

__device__ __forceinline__ float sgemm_item(const bf16_t* A, const bf16_t* Bt, int K, int n0, LAS float* red, int tid, int wid, int lane) {
    const int fr = lane & 15, fq = lane >> 4, kw = K >> 3, nks = kw >> 5;
    const bf16_t* ap = A + (size_t)fr * K + wid * kw + 8 * fq; const bf16_t* bp = Bt + (size_t)(n0 + fr) * K + wid * kw + 8 * fq;
    f32x4 c0 = {0.f, 0.f, 0.f, 0.f}, c1 = {0.f, 0.f, 0.f, 0.f};
    for (int ks = 0; ks < nks; ++ks) { const bf16x8 b = *(const bf16x8*)(bp + 32 * ks), a0 = *(const bf16x8*)(ap + 32 * ks), a1 = *(const bf16x8*)(ap + (size_t)16 * K + 32 * ks);
        c0 = __builtin_amdgcn_mfma_f32_16x16x32_bf16(b, a0, c0, 0, 0, 0); c1 = __builtin_amdgcn_mfma_f32_16x16x32_bf16(b, a1, c1, 0, 0, 0); }
    *(LAS f32x4*)(red + wid * 512 + fr * 16 + 4 * fq) = c0; *(LAS f32x4*)(red + wid * 512 + (16 + fr) * 16 + 4 * fq) = c1;
    __syncthreads();
    float s = 0.f;
#pragma unroll
    for (int w = 0; w < 8; ++w) s += red[w * 512 + tid];
    __syncthreads();
    return s;
}

__device__ __forceinline__ void attn_tile(const bf16_t* H, bf16_t* OG, float* LSE, int T, LAS unsigned char* lds, int tid, int wid, int lane) {
    const int fr = lane & 15, fq = lane >> 4;
    const int g = T >> 9, idx = T & 511, h = idx & 3, rr = idx >> 2, dsh = 2 * g, d = 1 << dsh, n = rr >> dsh, r = rr & (d - 1);
    const int colq = (g * 4 + h) * 64, colk = C_KA + colq, colv = C_VA + colq;
    LAS unsigned char* Ks = lds;
    LAS unsigned char* VT = lds + 36864;
#pragma unroll
    for (int it = 0; it < 4; ++it) { const int p = tid + 512 * it, key = p >> 3, ch = p & 7, kidx = (n - 1) * 128 + key;
        u32x4 v = {0u, 0u, 0u, 0u}; if (kidx >= 0) v = *(const u32x4*)(H + (size_t)(kidx * d + r) * INW + colk + ch * 8);
        *(LAS u32x4*)(Ks + key * 144 + ch * 16) = v; }
#pragma unroll
    for (int it = 0; it < 4; ++it) { const int key = it * 64 + lane, kidx = (n - 1) * 128 + key;
        u32x4 v = {0u, 0u, 0u, 0u}; if (kidx >= 0) v = *(const u32x4*)(H + (size_t)(kidx * d + r) * INW + colv + wid * 8);
        LAS unsigned short* vp = (LAS unsigned short*)(VT + (wid * 8) * 544 + key * 2);
        vp[0 * 272] = (unsigned short)(v.x & 0xffffu); vp[1 * 272] = (unsigned short)(v.x >> 16); vp[2 * 272] = (unsigned short)(v.y & 0xffffu); vp[3 * 272] = (unsigned short)(v.y >> 16);
        vp[4 * 272] = (unsigned short)(v.z & 0xffffu); vp[5 * 272] = (unsigned short)(v.z >> 16); vp[6 * 272] = (unsigned short)(v.w & 0xffffu); vp[7 * 272] = (unsigned short)(v.w >> 16); }
    if (tid < 128) *(LAS u32x4*)(VT + (tid >> 1) * 544 + 512 + (tid & 1) * 16) = (u32x4){0u, 0u, 0u, 0u};
    const int pos = ((n * 128 + 16 * wid + fr) << dsh) + r;
    bf16x8 qf[2];
#pragma unroll
    for (int ks = 0; ks < 2; ++ks) qf[ks] = *(const bf16x8*)(H + (size_t)pos * INW + colq + 8 * fq + 32 * ks);
    __syncthreads();
    f32x4 s[9];
#pragma unroll
    for (int t = 0; t < 9; ++t) { f32x4 acc = {0.f, 0.f, 0.f, 0.f};
#pragma unroll
        for (int ks = 0; ks < 2; ++ks) { const bf16x8 kf = *(const LAS bf16x8*)(Ks + (16 * (wid + t) + fr) * 144 + (8 * fq + 32 * ks) * 2); acc = __builtin_amdgcn_mfma_f32_16x16x32_bf16(kf, qf[ks], acc, 0, 0, 0); }
        s[t] = acc; }
    float mx = -1e30f;
#pragma unroll
    for (int t = 0; t < 9; ++t) { const bool blk_ok = (n > 0) || (wid + t >= 8);
#pragma unroll
        for (int i = 0; i < 4; ++i) { const int jj = 4 * fq + i; bool ok = blk_ok; if (t == 0) ok = ok && (jj >= fr); if (t == 8) ok = ok && (jj <= fr);
            const float v = ok ? s[t][i] : -1e30f; s[t][i] = v; mx = fmaxf(mx, v); } }
    mx = fmaxf(mx, __shfl_xor(mx, 16)); mx = fmaxf(mx, __shfl_xor(mx, 32));
    const float cs = 0.125f * 1.44269504f; float sum = 0.f;
#pragma unroll
    for (int t = 0; t < 9; ++t)
#pragma unroll
        for (int i = 0; i < 4; ++i) { const float p = __builtin_amdgcn_exp2f((s[t][i] - mx) * cs); s[t][i] = p; sum += p; }
    sum += __shfl_xor(sum, 16); sum += __shfl_xor(sum, 32);
    f32x4 o[4];
#pragma unroll
    for (int eb = 0; eb < 4; ++eb) o[eb] = (f32x4){0.f, 0.f, 0.f, 0.f};
#pragma unroll
    for (int c5 = 0; c5 < 5; ++c5) { const int t0 = 2 * c5, t1 = t0 + 1;
        u32x4 pw; pw.x = cvt_pk_bf16(s[t0][0], s[t0][1]); pw.y = cvt_pk_bf16(s[t0][2], s[t0][3]);
        if (t1 < 9) { pw.z = cvt_pk_bf16(s[t1 < 9 ? t1 : 0][0], s[t1 < 9 ? t1 : 0][1]); pw.w = cvt_pk_bf16(s[t1 < 9 ? t1 : 0][2], s[t1 < 9 ? t1 : 0][3]); } else { pw.z = 0u; pw.w = 0u; }
        const bf16x8 pf = __builtin_bit_cast(bf16x8, pw);
#pragma unroll
        for (int eb = 0; eb < 4; ++eb) { const LAS unsigned char* vp = VT + (16 * eb + fr) * 544 + (16 * (wid + t0) + 4 * fq) * 2;
            const u32x2 lo = *(const LAS u32x2*)vp, hi = *(const LAS u32x2*)(vp + 32);
            const u32x4 vw = {lo.x, lo.y, hi.x, hi.y};
            o[eb] = __builtin_amdgcn_mfma_f32_16x16x32_bf16(__builtin_bit_cast(bf16x8, vw), pf, o[eb], 0, 0, 0); } }
    const float inv = 1.0f / sum;
    bf16_t* op = OG + ((size_t)g * MV + pos) * 256 + h * 64 + 4 * fq;
#pragma unroll
    for (int eb = 0; eb < 4; ++eb) { u32x2 w; w.x = cvt_pk_bf16(o[eb][0] * inv, o[eb][1] * inv); w.y = cvt_pk_bf16(o[eb][2] * inv, o[eb][3] * inv); *(u32x2*)(op + 16 * eb) = w; }
    if (fq == 0) LSE[((size_t)g * MV + pos) * 4 + h] = mx * 0.125f + __builtin_amdgcn_logf(sum) * 0.69314718f;
    __syncthreads();
}

__device__ __forceinline__ void sattn_wg(const Args& a, const bf16_t* H, bf16_t* OA, int item, LAS float* sm, int tid, int wid, int lane) {
    const int b = item >> 2, h = item & 3; const size_t row = SQ + b;
    LAS float* qs = sm; LAS float* wmaxs = sm + 64; LAS float* wsums = sm + 80; LAS float* part = sm + 256;
    float og[3] = {0.f, 0.f, 0.f}, lg[3] = {0.f, 0.f, 0.f};
#pragma unroll
    for (int g = 0; g < 3; ++g) { const int d = 1 << (2 * g), Wb = 128 * d; const float* cache = a.in[3 + g]; const int colq = (g * 4 + h) * 64;
        const float qe = bf2f(H[row * INW + colq + lane]), kn = bf2f(H[row * INW + C_KA + colq + lane]);
        if (tid < 64) qs[tid] = qe;
        __syncthreads();
        const float s_new = wave_sum(qe * kn) * 0.125f;
        const int kl = lane >> 2, q4 = lane & 3, kk = 1 + wid * 16 + kl, ix = Wb - kk * d;
        const float* kp = cache + (((size_t)b * Wb + ix) * 2 + 0) * 256 + h * 64 + q4 * 16; float dot = 0.f;
#pragma unroll
        for (int e = 0; e < 16; e += 4) { const f32x4 k4 = *(const f32x4*)(kp + e); const f32x4 x4 = *(const LAS f32x4*)(qs + q4 * 16 + e); dot += k4[0] * x4[0] + k4[1] * x4[1] + k4[2] * x4[2] + k4[3] * x4[3]; }
        dot += __shfl_xor(dot, 1); dot += __shfl_xor(dot, 2);
        const float sc = dot * 0.125f;
        const float wm = wave_max(sc); if (lane == 0) wmaxs[wid] = wm;
        __syncthreads();
        float mx = s_new;
#pragma unroll
        for (int w = 0; w < 8; ++w) mx = fmaxf(mx, wmaxs[w]);
        const float p = __expf(sc - mx), pn = __expf(s_new - mx);
        const float psum = wave_sum(p) * 0.25f;
        const int e16 = lane & 15, kq = lane >> 4; f32x4 acc = {0.f, 0.f, 0.f, 0.f};
#pragma unroll
        for (int j = 0; j < 4; ++j) { const int kloc = kq * 4 + j; const float pk = __shfl(p, 4 * kloc); const int ix2 = Wb - (1 + wid * 16 + kloc) * d;
            const f32x4 v4 = *(const f32x4*)(cache + (((size_t)b * Wb + ix2) * 2 + 1) * 256 + h * 64 + e16 * 4); acc = acc + v4 * pk; }
#pragma unroll
        for (int j = 0; j < 4; ++j) { acc[j] += __shfl_xor(acc[j], 16); acc[j] += __shfl_xor(acc[j], 32); }
        if (lane < 16) *(LAS f32x4*)(part + wid * 64 + e16 * 4) = acc;
        if (lane == 0) wsums[wid] = psum;
        __syncthreads();
        if (tid < 64) { float o = pn * bf2f(H[row * INW + C_VA + colq + tid]), sum = pn;
#pragma unroll
            for (int w = 0; w < 8; ++w) { o += part[w * 64 + tid]; sum += wsums[w]; }
            og[g] = o / sum; lg[g] = mx + __logf(sum); }
        __syncthreads(); }
    if (tid < 64) { const float m = fmaxf(lg[0], fmaxf(lg[1], lg[2])); const float w0 = __expf(lg[0] - m), w1 = __expf(lg[1] - m), w2 = __expf(lg[2] - m);
        OA[row * 256 + h * 64 + tid] = f2bf((w0 * og[0] + w1 * og[1] + w2 * og[2]) / (w0 + w1 + w2)); }
}

__device__ __forceinline__ void mem_load_kv(const bf16_t* MKV, int h, LAS unsigned char* lds, int tid, int wid, int lane) {
    LAS unsigned char* Km = lds;
    LAS unsigned char* VT = lds + 69632;
#pragma unroll
    for (int it = 0; it < 8; ++it) { const int p = tid + 512 * it, key = p >> 4, ch = p & 15;
        *(LAS u32x4*)(Km + key * 272 + ch * 16) = *(const u32x4*)(MKV + (size_t)key * 1024 + h * 128 + ch * 8); }
#pragma unroll
    for (int it = 0; it < 8; ++it) { const int key = (it & 3) * 64 + lane, ch = wid + 8 * (it >> 2);
        const u32x4 v = *(const u32x4*)(MKV + (size_t)key * 1024 + 512 + h * 128 + ch * 8);
        LAS unsigned short* vp = (LAS unsigned short*)(VT + (ch * 8) * 544 + key * 2);
        vp[0 * 272] = (unsigned short)(v.x & 0xffffu); vp[1 * 272] = (unsigned short)(v.x >> 16); vp[2 * 272] = (unsigned short)(v.y & 0xffffu); vp[3 * 272] = (unsigned short)(v.y >> 16);
        vp[4 * 272] = (unsigned short)(v.z & 0xffffu); vp[5 * 272] = (unsigned short)(v.z >> 16); vp[6 * 272] = (unsigned short)(v.w & 0xffffu); vp[7 * 272] = (unsigned short)(v.w >> 16); }
    __syncthreads();
}
__device__ __forceinline__ void mem_tile(const bf16_t* H, bf16_t* OM, int h, int tile, LAS unsigned char* lds, int wid, int lane) {
    const int fr = lane & 15, fq = lane >> 4;
    const LAS unsigned char* Km = lds; const LAS unsigned char* VT = lds + 69632;
    const size_t row = (size_t)tile * 128 + 16 * wid + fr;
    bf16x8 qf[4];
#pragma unroll
    for (int ks = 0; ks < 4; ++ks) qf[ks] = *(const bf16x8*)(H + row * INW + C_QM + h * 128 + 8 * fq + 32 * ks);
    f32x4 s[16];
#pragma unroll
    for (int t = 0; t < 16; ++t) { f32x4 acc = {0.f, 0.f, 0.f, 0.f};
#pragma unroll
        for (int ks = 0; ks < 4; ++ks) { const bf16x8 kf = *(const LAS bf16x8*)(Km + (16 * t + fr) * 272 + (8 * fq + 32 * ks) * 2); acc = __builtin_amdgcn_mfma_f32_16x16x32_bf16(kf, qf[ks], acc, 0, 0, 0); }
        s[t] = acc; }
    float mx = -1e30f;
#pragma unroll
    for (int t = 0; t < 16; ++t)
#pragma unroll
        for (int i = 0; i < 4; ++i) mx = fmaxf(mx, s[t][i]);
    mx = fmaxf(mx, __shfl_xor(mx, 16)); mx = fmaxf(mx, __shfl_xor(mx, 32));
    const float cs = 0.08838834764831845f * 1.44269504f; float sum = 0.f;
#pragma unroll
    for (int t = 0; t < 16; ++t)
#pragma unroll
        for (int i = 0; i < 4; ++i) { const float p = __builtin_amdgcn_exp2f((s[t][i] - mx) * cs); s[t][i] = p; sum += p; }
    sum += __shfl_xor(sum, 16); sum += __shfl_xor(sum, 32);
    f32x4 o[8];
#pragma unroll
    for (int eb = 0; eb < 8; ++eb) o[eb] = (f32x4){0.f, 0.f, 0.f, 0.f};
#pragma unroll
    for (int c = 0; c < 8; ++c) { const int t0 = 2 * c, t1 = t0 + 1;
        u32x4 pw; pw.x = cvt_pk_bf16(s[t0][0], s[t0][1]); pw.y = cvt_pk_bf16(s[t0][2], s[t0][3]); pw.z = cvt_pk_bf16(s[t1][0], s[t1][1]); pw.w = cvt_pk_bf16(s[t1][2], s[t1][3]);
        const bf16x8 pf = __builtin_bit_cast(bf16x8, pw);
#pragma unroll
        for (int eb = 0; eb < 8; ++eb) { const LAS unsigned char* vp = VT + (16 * eb + fr) * 544 + (16 * t0 + 4 * fq) * 2;
            const u32x2 lo = *(const LAS u32x2*)vp, hi = *(const LAS u32x2*)(vp + 32);
            const u32x4 vw = {lo.x, lo.y, hi.x, hi.y};
            o[eb] = __builtin_amdgcn_mfma_f32_16x16x32_bf16(__builtin_bit_cast(bf16x8, vw), pf, o[eb], 0, 0, 0); } }
    const float inv = 1.0f / sum;
    bf16_t* op = OM + row * 512 + h * 128 + 4 * fq;
#pragma unroll
    for (int eb = 0; eb < 8; ++eb) { u32x2 w; w.x = cvt_pk_bf16(o[eb][0] * inv, o[eb][1] * inv); w.y = cvt_pk_bf16(o[eb][2] * inv, o[eb][3] * inv); *(u32x2*)(op + 16 * eb) = w; }
}
__device__ __forceinline__ void smem_wg(const Args& a, const bf16_t* H, bf16_t* OM, int item, LAS float* sm, int tid, int wid, int lane) {
    const int b = item >> 2, h = item & 3; const size_t row = SQ + b; const float* cm = a.in[6];
    LAS float* qs = sm; LAS float* wmaxs = sm + 128; LAS float* wsums = sm + 144; LAS float* part = sm + 256;
    if (tid < 128) qs[tid] = bf2f(H[row * INW + C_QM + h * 128 + tid]);
    __syncthreads();
    const int kl = lane >> 1, hf = lane & 1, key = wid * 32 + kl;
    const float* kp = cm + (((size_t)b * 256 + key) * 2 + 0) * 512 + h * 128 + hf * 64; float dot = 0.f;
#pragma unroll
    for (int e = 0; e < 64; e += 4) { const f32x4 k4 = *(const f32x4*)(kp + e); const f32x4 x4 = *(const LAS f32x4*)(qs + hf * 64 + e); dot += k4[0] * x4[0] + k4[1] * x4[1] + k4[2] * x4[2] + k4[3] * x4[3]; }
    dot += __shfl_xor(dot, 1);
    const float sc = dot * 0.08838834764831845f;
    const float wm = wave_max(sc); if (lane == 0) wmaxs[wid] = wm;
    __syncthreads();
    float mx = wmaxs[0];
#pragma unroll
    for (int w = 1; w < 8; ++w) mx = fmaxf(mx, wmaxs[w]);
    const float p = __expf(sc - mx); const float psum = wave_sum(p) * 0.5f;
    const int e32 = lane & 31, kq = lane >> 5; f32x4 acc = {0.f, 0.f, 0.f, 0.f};
#pragma unroll
    for (int j = 0; j < 16; ++j) { const int kloc = kq * 16 + j; const float pk = __shfl(p, 2 * kloc);
        const f32x4 v4 = *(const f32x4*)(cm + (((size_t)b * 256 + wid * 32 + kloc) * 2 + 1) * 512 + h * 128 + e32 * 4); acc = acc + v4 * pk; }
#pragma unroll
    for (int j = 0; j < 4; ++j) acc[j] += __shfl_xor(acc[j], 32);
    if (lane < 32) *(LAS f32x4*)(part + wid * 128 + e32 * 4) = acc;
    if (lane == 0) wsums[wid] = psum;
    __syncthreads();
    if (tid < 128) { float o = 0.f, sum = 0.f;
#pragma unroll
        for (int w = 0; w < 8; ++w) { o += part[w * 128 + tid]; sum += wsums[w]; }
        OM[row * 512 + h * 128 + tid] = f2bf(o / sum); }
    __syncthreads();
}

__device__ __forceinline__ void gmlp_item(const Args& a, const bf16_t* H, const float* vstat, const bf16_t* WSB, bf16_t* OB, int item, LAS unsigned char* lds, int tid, int wid, int lane) {
    const int fr = lane & 15, fq = lane >> 4, n = item >> 2, g = item & 3, t0 = n * 128;
    LAS unsigned char* VT = lds;
    LAS unsigned char* Wl = lds + 52224;
#pragma unroll
    for (int it = 0; it < 4; ++it) { const int p = tid + 512 * it, i = p >> 4, ch = p & 15;
        *(LAS u32x4*)(Wl + i * 272 + ch * 16) = *(const u32x4*)(WSB + (size_t)g * 16384 + i * 128 + ch * 8); }
    const float* lng = a.in[10]; const float* lnb = a.in[11];
#pragma unroll
    for (int it = 0; it < 6; ++it) { const int j = (it & 1) * 64 + lane, ch = wid + 8 * (it >> 1), c0 = g * 192 + ch * 8;
        const size_t row = (size_t)t0 + j;
        const u32x4 v = *(const u32x4*)(H + row * INW + C_VB + c0);
        const float mean = vstat[2 * row] * (1.0f / 768.0f), var = vstat[2 * row + 1] * (1.0f / 768.0f) - mean * mean, rstd = __builtin_amdgcn_rsqf(var + LN_EPS);
        const f32x4 g0 = *(const f32x4*)(lng + c0), g1 = *(const f32x4*)(lng + c0 + 4), b0 = *(const f32x4*)(lnb + c0), b1 = *(const f32x4*)(lnb + c0 + 4);
        LAS unsigned short* vp = (LAS unsigned short*)(VT + (ch * 8) * 272 + j * 2);
        vp[0 * 136] = f2bf((bflo(v.x) - mean) * rstd * g0[0] + b0[0]); vp[1 * 136] = f2bf((bfhi(v.x) - mean) * rstd * g0[1] + b0[1]);
        vp[2 * 136] = f2bf((bflo(v.y) - mean) * rstd * g0[2] + b0[2]); vp[3 * 136] = f2bf((bfhi(v.y) - mean) * rstd * g0[3] + b0[3]);
        vp[4 * 136] = f2bf((bflo(v.z) - mean) * rstd * g1[0] + b1[0]); vp[5 * 136] = f2bf((bfhi(v.z) - mean) * rstd * g1[1] + b1[1]);
        vp[6 * 136] = f2bf((bflo(v.w) - mean) * rstd * g1[2] + b1[2]); vp[7 * 136] = f2bf((bfhi(v.w) - mean) * rstd * g1[3] + b1[3]); }
    __syncthreads();
    f32x4 acc[12];
#pragma unroll
    for (int cb = 0; cb < 12; ++cb) acc[cb] = (f32x4){0.f, 0.f, 0.f, 0.f};
    const int nks = (wid >> 1) + 1;
    for (int ks = 0; ks < nks; ++ks) { const bf16x8 wf = *(const LAS bf16x8*)(Wl + (16 * wid + fr) * 272 + (8 * fq + 32 * ks) * 2);
#pragma unroll
        for (int cb = 0; cb < 12; ++cb) { const bf16x8 vf = *(const LAS bf16x8*)(VT + (16 * cb + fr) * 272 + (8 * fq + 32 * ks) * 2);
            acc[cb] = __builtin_amdgcn_mfma_f32_16x16x32_bf16(vf, wf, acc[cb], 0, 0, 0); } }
    const size_t row = (size_t)t0 + 16 * wid + fr; const float bsv = a.in[13][g * 128 + 16 * wid + fr];
#pragma unroll
    for (int cb = 0; cb < 12; ++cb) { const int c = g * 192 + 16 * cb + 4 * fq;
        const u32x2 uw = *(const u32x2*)(H + row * INW + C_UB + c);
        u32x2 w; w.x = cvt_pk_bf16(bflo(uw.x) * (acc[cb][0] + bsv), bfhi(uw.x) * (acc[cb][1] + bsv)); w.y = cvt_pk_bf16(bflo(uw.y) * (acc[cb][2] + bsv), bfhi(uw.y) * (acc[cb][3] + bsv));
        *(u32x2*)(OB + row * 768 + c) = w; }
    __syncthreads();
}
__device__ __forceinline__ void sgmlp_item(const Args& a, const bf16_t* H, const float* vstat, bf16_t* OB, int b, int lane) {
    const size_t row = SQ + b; const float* lng = a.in[10]; const float* lnb = a.in[11]; const float* wsp = a.in[12]; const float* bsp = a.in[13];
    const float mean = vstat[2 * row] * (1.0f / 768.0f), var = vstat[2 * row + 1] * (1.0f / 768.0f) - mean * mean, rstd = __builtin_amdgcn_rsqf(var + LN_EPS);
    float* gv = a.out + O_GV + (size_t)b * 768;
#pragma unroll
    for (int jj = 0; jj < 3; ++jj) { const int c = 4 * lane + 256 * jj;
        const u32x2 vw = *(const u32x2*)(H + row * INW + C_VB + c), uw = *(const u32x2*)(H + row * INW + C_UB + c);
        const f32x4 g4 = *(const f32x4*)(lng + c), b4 = *(const f32x4*)(lnb + c);
        f32x4 vn; vn[0] = (bflo(vw.x) - mean) * rstd * g4[0] + b4[0]; vn[1] = (bfhi(vw.x) - mean) * rstd * g4[1] + b4[1]; vn[2] = (bflo(vw.y) - mean) * rstd * g4[2] + b4[2]; vn[3] = (bfhi(vw.y) - mean) * rstd * g4[3] + b4[3];
        *(f32x4*)(gv + c) = vn;
        const int gg = c / 192; const float w00 = wsp[gg * 16384], b00 = bsp[gg * 128];
        u32x2 w; w.x = cvt_pk_bf16(bflo(uw.x) * (w00 * vn[0] + b00), bfhi(uw.x) * (w00 * vn[1] + b00)); w.y = cvt_pk_bf16(bflo(uw.y) * (w00 * vn[2] + b00), bfhi(uw.y) * (w00 * vn[3] + b00));
        *(u32x2*)(OB + row * 768 + c) = w; }
}

__device__ __forceinline__ void ln_row(const float* in, const float* gam, const float* bet, float* out32, bf16_t* out16, int lane) {
    f32x4 v[4]; float s = 0.f;
#pragma unroll
    for (int j = 0; j < 4; ++j) { v[j] = *(const f32x4*)(in + 4 * lane + 256 * j); s += (v[j][0] + v[j][1]) + (v[j][2] + v[j][3]); }
    const float mean = wave_sum(s) * (1.0f / 1024.0f); float s2 = 0.f;
#pragma unroll
    for (int j = 0; j < 4; ++j) { v[j] = v[j] - mean; s2 += (v[j][0] * v[j][0] + v[j][1] * v[j][1]) + (v[j][2] * v[j][2] + v[j][3] * v[j][3]); }
    const float rstd = __builtin_amdgcn_rsqf(wave_sum(s2) * (1.0f / 1024.0f) + LN_EPS);
#pragma unroll
    for (int j = 0; j < 4; ++j) { const f32x4 g4 = *(const f32x4*)(gam + 4 * lane + 256 * j), b4 = *(const f32x4*)(bet + 4 * lane + 256 * j);
        const f32x4 y = v[j] * rstd * g4 + b4;
        *(f32x4*)(out32 + 4 * lane + 256 * j) = y;
        if (out16) { u32x2 w; w.x = cvt_pk_bf16(y[0], y[1]); w.y = cvt_pk_bf16(y[2], y[3]); *(u32x2*)(out16 + 4 * lane + 256 * j) = w; } }
}

#define XB_TMO      128
#define XB_XCNT(j)  (256  + 64 * (j))
#define XB_XSUB(j)  (1280 + 64 * (j))
#define XB_XGEN(j)  (2304 + 64 * (j))
#define XB_TOP      3328
#define XB_TOPGEN   3392
#define XCD_BAR_WORDS 3456
#define XB_SPIN_CAP (1u << 18)

__device__ __forceinline__ unsigned xb_ld(unsigned* p)              { return __hip_atomic_load(p, __ATOMIC_RELAXED, __HIP_MEMORY_SCOPE_AGENT); }
__device__ __forceinline__ unsigned xb_add(unsigned* p, unsigned v) { return __hip_atomic_fetch_add(p, v, __ATOMIC_RELAXED, __HIP_MEMORY_SCOPE_AGENT); }
__device__ __forceinline__ unsigned xb_xcc_id() { return (unsigned)__builtin_amdgcn_s_getreg((3 << 11) | 20) & 0xFu; }
#define XB_SPIN(cond, bar) do { unsigned _sp = 0; while (cond) { __builtin_amdgcn_s_sleep(1); \
    if ((++_sp & 255u) == 0u) { if (xb_ld(&(bar)[XB_TMO])) break; if (_sp > XB_SPIN_CAP) { atomicAdd(&(bar)[XB_TMO], 1u); break; } } } } while (0)

struct XcdBarrier {
    unsigned* bar; unsigned x;
    volatile LAS unsigned* st;
};

__device__ __forceinline__ XcdBarrier xcd_barrier_post(unsigned* bar, volatile LAS unsigned* st) {
    XcdBarrier b; b.bar = bar; b.x = xb_xcc_id(); b.st = st;
    if (threadIdx.x == 0) (void)xb_add(&bar[XB_XCNT(b.x)], 1u);
    return b;
}
__device__ __forceinline__ void xcd_barrier_complete(unsigned* bar, unsigned x, unsigned& nloc, unsigned& nx) {
    const unsigned G = gridDim.x * gridDim.y * gridDim.z;
    unsigned sum, cnt, mine, sp = 0u;
    for (;;) {
        sum = 0u; cnt = 0u; mine = 0u;
#pragma unroll
        for (unsigned j = 0; j < 16; ++j) { const unsigned c = xb_ld(&bar[XB_XCNT(j)]); sum += c; cnt += (c > 0u) ? 1u : 0u; mine = (j == x) ? c : mine; }
        if (sum == G) break;
        __builtin_amdgcn_s_sleep(1);
        if ((++sp & 255u) == 0u) { if (xb_ld(&bar[XB_TMO])) break; if (sp > XB_SPIN_CAP) { atomicAdd(&bar[XB_TMO], 1u); break; } }
    }
    nloc = mine > 0u ? mine : 1u; nx = cnt > 0u ? cnt : 1u;
}

__device__ __forceinline__ void xcd_barrier(const XcdBarrier& b) {
    asm volatile("s_waitcnt vmcnt(0)" ::: "memory");
    __syncthreads();
    if (threadIdx.x == 0) {
        unsigned* bar = b.bar;
        __builtin_amdgcn_s_waitcnt(0);
        unsigned nloc = b.st[0], nx = b.st[1];
        if (nloc == 0u) { xcd_barrier_complete(bar, b.x, nloc, nx); b.st[0] = nloc; b.st[1] = nx; }
        const unsigned old = xb_add(&bar[XB_XSUB(b.x)], 1u);
        const unsigned gen = old / nloc;
        if (old + 1u == (gen + 1u) * nloc) {
            __builtin_amdgcn_fence(__ATOMIC_RELEASE, "agent");
            asm volatile("s_waitcnt vmcnt(0)" ::: "memory");
            const unsigned og = xb_add(&bar[XB_TOP], 1u);
            const unsigned tg = og / nx;
            if (og + 1u == (tg + 1u) * nx) xb_add(&bar[XB_TOPGEN], 1u);
            else XB_SPIN(xb_ld(&bar[XB_TOPGEN]) == tg, bar);
            __builtin_amdgcn_fence(__ATOMIC_ACQUIRE, "agent");
            xb_add(&bar[XB_XGEN(b.x)], 1u);
            asm volatile("s_waitcnt vmcnt(0)" ::: "memory");
        } else {
            XB_SPIN(xb_ld(&bar[XB_XGEN(b.x)]) == gen, bar);
            __builtin_amdgcn_fence(__ATOMIC_ACQUIRE, "agent");
            asm volatile("s_waitcnt vmcnt(0)" ::: "memory");
        }
    }
    __syncthreads();
}

__global__ void __launch_bounds__(512, 2) mega(Args a) {
    extern __shared__ __attribute__((aligned(16))) unsigned char lds_raw[];
    cg::grid_group grid = cg::this_grid();
    LAS unsigned char* lds = (LAS unsigned char*)lds_raw;
    const int tid = threadIdx.x, lane = tid & 63, wid = __builtin_amdgcn_readfirstlane(tid >> 6);
    const int bx = blockIdx.x, G = gridDim.x;
    const size_t gt = (size_t)bx * 512 + tid, GT = (size_t)G * 512;
    const int gw = bx * 8 + wid, NGW = G * 8;
    unsigned char* ws = a.ws;
    float* VSTAT = (float*)(ws + WS_VSTAT);
    bf16_t* WinT = (bf16_t*)(ws + WS_WIN); bf16_t* WmemT = (bf16_t*)(ws + WS_WMEM); bf16_t* WbaT = (bf16_t*)(ws + WS_WBA); bf16_t* WbbT = (bf16_t*)(ws + WS_WBB);
    bf16_t* WbmT = (bf16_t*)(ws + WS_WBM); bf16_t* WoutT = (bf16_t*)(ws + WS_WOUT); bf16_t* WupT = (bf16_t*)(ws + WS_WUP); bf16_t* WdownT = (bf16_t*)(ws + WS_WDOWN);
    bf16_t* WSB = (bf16_t*)(ws + WS_WSB); bf16_t* MEMB = (bf16_t*)(ws + WS_MEMB); bf16_t* MKV = (bf16_t*)(ws + WS_MKV);
    bf16_t* XB = (bf16_t*)(ws + WS_XB); bf16_t* H = (bf16_t*)(ws + WS_H); bf16_t* OG = (bf16_t*)(ws + WS_OG); float* LSE = (float*)(ws + WS_LSE);
    bf16_t* OA = (bf16_t*)(ws + WS_OA); bf16_t* OB = (bf16_t*)(ws + WS_OB); bf16_t* OM = (bf16_t*)(ws + WS_OM); bf16_t* MIX = (bf16_t*)(ws + WS_MIX);
    float* Z1 = (float*)(ws + WS_Z1); bf16_t* X1B = (bf16_t*)(ws + WS_X1B); bf16_t* U = (bf16_t*)(ws + WS_U); bf16_t* HH = (bf16_t*)(ws + WS_HH);
    LAS float* red = (LAS float*)lds;

    unsigned* barw = (unsigned*)(ws + WS_BAR);
    volatile LAS unsigned* bst = (volatile LAS unsigned*)(lds + LDS_BYTES - 16);
    if (tid < 4) bst[tid] = 0u;
    if (bx == 0) for (int i = tid; i < XCD_BAR_WORDS; i += 512) barw[i] = 0u;
    __syncthreads();
    p0_prologue(a, lds, tid, wid, lane);
    grid.sync();
    const XcdBarrier xbar = xcd_barrier_post(barw, bst);

    for (int it = bx; it < INW / 16; it += G) { const int n0 = it * 16;
        const float v = sgemm_item(XB + (size_t)SQ * DM, WinT, DM, n0, red, tid, wid, lane);
        const int r = tid >> 4, col = n0 + (tid & 15); const size_t row = SQ + r; float o = v;
        if (col >= C_UB && col < C_QM) { o = gelu_t(v); if (col >= C_VB) { __hip_atomic_fetch_add(VSTAT + 2 * row, o, __ATOMIC_RELAXED, __HIP_MEMORY_SCOPE_AGENT); __hip_atomic_fetch_add(VSTAT + 2 * row + 1, o * o, __ATOMIC_RELAXED, __HIP_MEMORY_SCOPE_AGENT); } }
        H[row * INW + col] = f2bf(o); }
    { pg8::Gemm g{XB, WinT, SQ, INW, DM}; pg8::StaticOrder S; S.init(SQ, INW, G, bx);
      pg8::EpiIn E{H, INW, VSTAT};
      pg8::gemm_phase<pg8::EpiIn, pg8::StaticOrder, true, true>(lds, g, S, E); }
    { pg8::Gemm g{MEMB, WmemT, NMEM, 1024, DM}; pg8::StaticOrder S; S.init(NMEM, 1024, G, (bx + 128) % G);
      pg8::EpiMem E{a.out + O_MEMP, MKV};
      pg8::gemm_phase<pg8::EpiMem, pg8::StaticOrder, true, true>(lds, g, S, E); }
    xcd_barrier(xbar);

    for (int T = bx; T < 1536; T += G) attn_tile(H, OG, LSE, T, lds, tid, wid, lane);
    if (bx < 128) sattn_wg(a, H, OA, bx, (LAS float*)lds, tid, wid, lane); else if (bx < 256) smem_wg(a, H, OM, bx - 128, (LAS float*)lds, tid, wid, lane);
    {
        const size_t oP[3] = {O_W128P, O_W512P, O_W2048P}, oS[3] = {O_W128S, O_W512S, O_W2048S};
#pragma unroll
        for (int g = 0; g < 3; ++g) { const int keep = 128 << (2 * g); float* op = a.out + oP[g]; float* os = a.out + oS[g];
            for (size_t i = gt; i < (size_t)keep * 512; i += GT) { const int p = (int)(i >> 9), kv = (int)(i >> 8) & 1, he = (int)i & 255;
                op[i] = bf2f(H[(size_t)(SQ - keep + p) * INW + (kv ? C_VA : C_KA) + g * 256 + he]); }
            for (size_t i = gt; i < (size_t)NSMP * 512; i += GT) { const int b = (int)(i >> 9), kv = (int)(i >> 8) & 1, he = (int)i & 255;
                os[i] = bf2f(H[(size_t)(SQ + b) * INW + (kv ? C_VA : C_KA) + g * 256 + he]); } }
    }
    xcd_barrier(xbar);

    for (size_t i = gt; i < (size_t)SQ * 32; i += GT) { const size_t tok = i >> 5; const int h = (int)(i >> 3) & 3, e8 = (int)i & 7;
        const float l0 = LSE[(0 * (size_t)MV + tok) * 4 + h], l1 = LSE[(1 * (size_t)MV + tok) * 4 + h], l2 = LSE[(2 * (size_t)MV + tok) * 4 + h];
        const float m = fmaxf(l0, fmaxf(l1, l2)); float w0 = __expf(l0 - m), w1 = __expf(l1 - m), w2 = __expf(l2 - m); const float inv = 1.0f / (w0 + w1 + w2); w0 *= inv; w1 *= inv; w2 *= inv;
        const u32x4 x0 = *(const u32x4*)(OG + (0 * (size_t)MV + tok) * 256 + h * 64 + e8 * 8), x1 = *(const u32x4*)(OG + (1 * (size_t)MV + tok) * 256 + h * 64 + e8 * 8), x2 = *(const u32x4*)(OG + (2 * (size_t)MV + tok) * 256 + h * 64 + e8 * 8);
        u32x4 w;
        w.x = cvt_pk_bf16(w0 * bflo(x0.x) + w1 * bflo(x1.x) + w2 * bflo(x2.x), w0 * bfhi(x0.x) + w1 * bfhi(x1.x) + w2 * bfhi(x2.x));
        w.y = cvt_pk_bf16(w0 * bflo(x0.y) + w1 * bflo(x1.y) + w2 * bflo(x2.y), w0 * bfhi(x0.y) + w1 * bfhi(x1.y) + w2 * bfhi(x2.y));
        w.z = cvt_pk_bf16(w0 * bflo(x0.z) + w1 * bflo(x1.z) + w2 * bflo(x2.z), w0 * bfhi(x0.z) + w1 * bfhi(x1.z) + w2 * bfhi(x2.z));
        w.w = cvt_pk_bf16(w0 * bflo(x0.w) + w1 * bflo(x1.w) + w2 * bflo(x2.w), w0 * bfhi(x0.w) + w1 * bfhi(x1.w) + w2 * bfhi(x2.w));
        *(u32x4*)(OA + tok * 256 + h * 64 + e8 * 8) = w; }
    {
        const int h = bx & 3; mem_load_kv(MKV, h, lds, tid, wid, lane);
        for (int tile = bx >> 2; tile < SQ / 128; tile += (G >> 2)) mem_tile(H, OM, h, tile, lds, wid, lane);
        __syncthreads(); }
    for (int it = bx; it < 512; it += G) gmlp_item(a, H, VSTAT, WSB, OB, it, lds, tid, wid, lane);
    if (wid == 2 && bx >= 128 && bx < 160) sgmlp_item(a, H, VSTAT, OB, bx - 128, lane);
    xcd_barrier(xbar);

    for (int it = bx; it < DM / 16; it += G) { const int n0 = it * 16; const int r = tid >> 4, col = n0 + (tid & 15); const size_t row = SQ + r;
        const float va = sgemm_item(OA + (size_t)SQ * 256, WbaT, 256, n0, red, tid, wid, lane);
        const float vb = sgemm_item(OB + (size_t)SQ * 768, WbbT, 768, n0, red, tid, wid, lane);
        const float vm = sgemm_item(OM + (size_t)SQ * 512, WbmT, 512, n0, red, tid, wid, lane);
        const float* bg = a.in[9]; const bf16_t* hg = H + row * INW + C_GT + col;
        const float o = sigm(bf2f(hg[0]) + bg[col]) * va + sigm(bf2f(hg[1024]) + bg[1024 + col]) * vb + sigm(bf2f(hg[2048]) + bg[2048 + col]) * vm;
        MIX[row * 1024 + col] = f2bf(o); }
    { pg8::StaticOrder S; S.init(SQ, DM, G, bx);
      { pg8::Gemm g{OA, WbaT, SQ, DM, 256}; pg8::EpiGate E{H + C_GT, INW, a.in[9], MIX, 1}; pg8::gemm_phase<pg8::EpiGate, pg8::StaticOrder, true, true>(lds, g, S, E); }
      { pg8::Gemm g{OB, WbbT, SQ, DM, 768}; pg8::EpiGate E{H + C_GT + 1024, INW, a.in[9] + 1024, MIX, 0}; pg8::gemm_phase<pg8::EpiGate, pg8::StaticOrder, true, true>(lds, g, S, E); }
      { pg8::Gemm g{OM, WbmT, SQ, DM, 512}; pg8::EpiGate E{H + C_GT + 2048, INW, a.in[9] + 2048, MIX, 0}; pg8::gemm_phase<pg8::EpiGate, pg8::StaticOrder, true, true>(lds, g, S, E); } }
    xcd_barrier(xbar);

    for (int it = bx; it < DM / 16; it += G) { const int n0 = it * 16; const int r = tid >> 4, col = n0 + (tid & 15);
        const float v = sgemm_item(MIX + (size_t)SQ * DM, WoutT, DM, n0, red, tid, wid, lane);
        Z1[(size_t)(SQ + r) * DM + col] = ALPHA * a.in[1][r * DM + col] + v; }
    { pg8::Gemm g{MIX, WoutT, SQ, DM, DM}; pg8::StaticOrder S; S.init(SQ, DM, G, bx);
      pg8::EpiRes E{a.in[0], Z1, ALPHA};
      pg8::gemm_phase<pg8::EpiRes, pg8::StaticOrder, true, true>(lds, g, S, E); }
    xcd_barrier(xbar);

    for (int row = gw; row < MV; row += NGW) ln_row(Z1 + (size_t)row * DM, a.in[19], a.in[20], Z1 + (size_t)row * DM, X1B + (size_t)row * DM, lane);
    xcd_barrier(xbar);

    for (int it = bx; it < 2 * DFF / 16; it += G) { const int n0 = it * 16; const int r = tid >> 4, col = n0 + (tid & 15);
        const float v = sgemm_item(X1B + (size_t)SQ * DM, WupT, DM, n0, red, tid, wid, lane);
        U[(size_t)(SQ + r) * (2 * DFF) + col] = f2bf(v); }
    { pg8::Gemm g{X1B, WupT, SQ, 2 * DFF, DM}; pg8::StaticOrder S; S.init(SQ, 2 * DFF, G, bx);
      pg8::EpiBf16P E{U, 2 * DFF};
      pg8::gemm_phase<pg8::EpiBf16P, pg8::StaticOrder, true, true>(lds, g, S, E); }
    xcd_barrier(xbar);

    { const float* cw = a.in[22]; const float* cb = a.in[23]; const float* st = a.in[7];
      for (size_t i = gt; i < (size_t)MV * (DFF / 8); i += GT) { const size_t row = i / (DFF / 8); const int c = (int)(i % (DFF / 8)) * 8;
        const u32x4 aw = *(const u32x4*)(U + row * (2 * DFF) + c), vw = *(const u32x4*)(U + row * (2 * DFF) + DFF + c);
        float a0[8] = {bflo(aw.x), bfhi(aw.x), bflo(aw.y), bfhi(aw.y), bflo(aw.z), bfhi(aw.z), bflo(aw.w), bfhi(aw.w)};
        float vv[8] = {bflo(vw.x), bfhi(vw.x), bflo(vw.y), bfhi(vw.y), bflo(vw.z), bfhi(vw.z), bflo(vw.w), bfhi(vw.w)};
        float a1[8], a2[8];
        if (row < SQ) {
            u32x4 w1 = {0u, 0u, 0u, 0u}, w2 = {0u, 0u, 0u, 0u};
            if (row >= 1) w1 = *(const u32x4*)(U + (row - 1) * (2 * DFF) + c);
            if (row >= 2) w2 = *(const u32x4*)(U + (row - 2) * (2 * DFF) + c);
            a1[0] = bflo(w1.x); a1[1] = bfhi(w1.x); a1[2] = bflo(w1.y); a1[3] = bfhi(w1.y); a1[4] = bflo(w1.z); a1[5] = bfhi(w1.z); a1[6] = bflo(w1.w); a1[7] = bfhi(w1.w);
            a2[0] = bflo(w2.x); a2[1] = bfhi(w2.x); a2[2] = bflo(w2.y); a2[3] = bfhi(w2.y); a2[4] = bflo(w2.z); a2[5] = bfhi(w2.z); a2[6] = bflo(w2.w); a2[7] = bfhi(w2.w);
            if (row >= SQ - 2) { float* op = a.out + O_CONVP + (row - (SQ - 2)) * DFF + c;
#pragma unroll
                for (int j = 0; j < 8; ++j) op[j] = a0[j]; }
        } else { const size_t b = row - SQ; const float* s0 = st + (b * 2 + 0) * DFF + c; const float* s1 = st + (b * 2 + 1) * DFF + c; float* op = a.out + O_CONVS + b * 2 * DFF + c;
#pragma unroll
            for (int j = 0; j < 8; ++j) { a2[j] = s0[j]; a1[j] = s1[j]; op[j] = s1[j]; op[DFF + j] = a0[j]; } }
        float hv[8];
#pragma unroll
        for (int j = 0; j < 8; ++j) { const float cv = cb[c + j] + cw[c + j] * a2[j] + cw[DFF + c + j] * a1[j] + cw[2 * DFF + c + j] * a0[j]; hv[j] = gelu_t(cv) * vv[j]; }
        u32x4 w; w.x = cvt_pk_bf16(hv[0], hv[1]); w.y = cvt_pk_bf16(hv[2], hv[3]); w.z = cvt_pk_bf16(hv[4], hv[5]); w.w = cvt_pk_bf16(hv[6], hv[7]);
        *(u32x4*)(HH + row * DFF + c) = w; } }
    xcd_barrier(xbar);

    for (int it = bx; it < DM / 16; it += G) { const int n0 = it * 16; const int r = tid >> 4, col = n0 + (tid & 15);
        const float v = sgemm_item(HH + (size_t)SQ * DFF, WdownT, DFF, n0, red, tid, wid, lane);
        float* zp = Z1 + (size_t)(SQ + r) * DM + col; *zp = ALPHA * (*zp) + v; }
    { pg8::Gemm g{HH, WdownT, SQ, DM, DFF}; pg8::StaticOrder S; S.init(SQ, DM, G, bx);
      pg8::EpiRes E{Z1, Z1, ALPHA};
      pg8::gemm_phase<pg8::EpiRes, pg8::StaticOrder, true, true>(lds, g, S, E); }
    xcd_barrier(xbar);

    for (int row = gw; row < MV; row += NGW) ln_row(Z1 + (size_t)row * DM, a.in[25], a.in[26], a.out + (row < SQ ? O_YP + (size_t)row * DM : O_YS + (size_t)(row - SQ) * DM), nullptr, lane);
}

extern "C" void kernel_launch(void* const* d_in, const int* in_sizes, int n_in, void* d_out, int out_size, void* d_ws, size_t ws_size, hipStream_t stream) {
    static int grid = 0;
    if (grid == 0) {
        if (n_in != 27 || (size_t)out_size != O_END || ws_size < WS_END || in_sizes[0] != SQ * DM) { fprintf(stderr, "kernel_launch: unexpected shapes: n_in %d out %d ws %zu\n", n_in, out_size, ws_size); grid = -1; return; }
        int dev = 0, cus = 0, per_cu = 0;
        if (hipGetDevice(&dev) != hipSuccess || hipDeviceGetAttribute(&cus, hipDeviceAttributeMultiprocessorCount, dev) != hipSuccess) { grid = -1; return; }
        if (hipFuncSetAttribute((const void*)mega, hipFuncAttributeMaxDynamicSharedMemorySize, LDS_BYTES) != hipSuccess) { fprintf(stderr, "kernel_launch: hipFuncSetAttribute failed\n"); grid = -1; return; }
        if (hipOccupancyMaxActiveBlocksPerMultiprocessor(&per_cu, (const void*)mega, 512, LDS_BYTES) != hipSuccess || per_cu < 1) { fprintf(stderr, "kernel_launch: occupancy query reports %d blocks per CU\n", per_cu); grid = -1; return; }
        grid = cus;
        if (grid % 4 != 0) grid -= grid % 4;
    }
    if (grid <= 0) return;
    Args a{};
    for (int i = 0; i < 27; ++i) a.in[i] = (const float*)d_in[i];
    a.out = (float*)d_out; a.ws = (unsigned char*)d_ws;
    void* args[] = {&a};
    hipError_t e = hipLaunchCooperativeKernel((const void*)mega, dim3(grid), dim3(512), args, LDS_BYTES, stream);
    if (e != hipSuccess) fprintf(stderr, "kernel_launch: cooperative launch failed: %s (grid %d)\n", hipGetErrorString(e), grid);
}
```

```cpp
#include <hip/hip_runtime.h>
#include <hip/hip_cooperative_groups.h>
#include <cstdio>
#include <cstdint>
namespace cg = cooperative_groups;

namespace pg8 {
#define PG8_LAS __attribute__((address_space(3)))
typedef unsigned short bf16_t;
typedef short bf16x8 __attribute__((ext_vector_type(8)));
typedef float f32x4 __attribute__((ext_vector_type(4)));
typedef unsigned u32x4 __attribute__((ext_vector_type(4)));
typedef float f32x2 __attribute__((ext_vector_type(2)));
constexpr int BM = 256, BK = 64, HALF = 128, HTB = HALF * BK * 2  , STAGE_BYTES = 8 * HTB, NXCD = 8, WGM = 8;

__host__ __device__ __forceinline__ int lds_byte(int r, int c) { const int st = (r >> 4) * 2 + (c >> 5), rr = r & 15, cc = c & 31, ob = rr * 64 + cc * 2; return st * 1024 + (ob ^ (((ob >> 9) & 1) << 5)); }
__host__ __device__ __forceinline__ void stage_rc(int b, int& R, int& C) { const int st = b / 1024, sb = b % 1024, swz = sb ^ (((sb >> 9) & 1) << 5); R = (st >> 1) * 16 + swz / 64; C = (st & 1) * 32 + (swz % 64) / 2; }
__host__ __device__ __forceinline__ int perm32(int rho) { const int n = rho >> 4, i = rho & 15; return 8 * (i >> 2) + 4 * n + (i & 3); }

struct Unit { int pm, pn; };
struct Gemm { const bf16_t* A; const bf16_t* Bt; int M, N, K; size_t pstepA; };

struct StaticOrder {
    int nM, nN, nwg, G, c;
    __host__ __device__ void init(int M, int N, int G_, int c_) { nM = M / BM; nN = N / BM; nwg = nM * nN; G = G_; c = c_; }
    __host__ __device__ bool next(int i, Unit& u) const {
        const long L = (long)i * G + c; if (L >= nwg) return false;
        int wgid = (int)L; { const int q = nwg / NXCD, r = nwg % NXCD, xcd = wgid % NXCD, off = wgid / NXCD; wgid = (xcd < r ? xcd * (q + 1) : r * (q + 1) + (xcd - r) * q) + off; }
        const int nig = WGM * nN, gid = wgid / nig, fm = gid * WGM, gsz = (nM - fm) < WGM ? (nM - fm) : WGM;
        u.pm = fm + ((wgid % nig) % gsz); u.pn = (wgid % nig) / gsz; return true;
    }
    __device__ __forceinline__ void a_ready(const Unit&) const {}
    __device__ __forceinline__ void done(const Unit&) const {}
};
__device__ __forceinline__ unsigned cvt_pk_bf16(float lo, float hi) { unsigned r; asm volatile("v_cvt_pk_bf16_f32 %0, %1, %2" : "=v"(r) : "v"(lo), "v"(hi)); return r; }
__device__ __forceinline__ float bflo(unsigned w) { return __uint_as_float(w << 16); }
__device__ __forceinline__ float bfhi(unsigned w) { return __uint_as_float(w & 0xffff0000u); }
__device__ __forceinline__ float bf2f(bf16_t b) { return __uint_as_float(((unsigned)b) << 16); }
__device__ __forceinline__ bf16_t f2bf(float f) { return (bf16_t)(cvt_pk_bf16(f, 0.f) & 0xffffu); }
__device__ __forceinline__ float gelu_t(float x) { const float u = x * (1.0f + 0.044715f * x * x); return x * __builtin_amdgcn_rcpf(1.0f + __builtin_amdgcn_exp2f(-2.3022082f * u)); }
__device__ __forceinline__ float sigm(float x) { return __builtin_amdgcn_rcpf(1.0f + __builtin_amdgcn_exp2f(-1.44269504f * x)); }

struct EpiBf16P {
    static constexpr bool PERM = true, AFTER_DRAIN = false;
    bf16_t* O; int ldc;
    __device__ __forceinline__ void operator()(const f32x4 (&acc)[2][2][4][2], const Unit& u, int wr, int wc, int fr, int fq) const {
        const int row0 = u.pm * BM + wr * 64 + fr, col0 = u.pn * BM + wc * 32 + 8 * fq;
#pragma unroll
        for (int ai = 0; ai < 2; ++ai)
#pragma unroll
            for (int m = 0; m < 4; ++m) { bf16_t* rowp = O + (size_t)(row0 + ai * HALF + m * 16) * ldc + col0;
#pragma unroll
                for (int bj = 0; bj < 2; ++bj) { const f32x4 v0 = acc[ai][bj][m][0], v1 = acc[ai][bj][m][1];
                    u32x4 w; w.x = cvt_pk_bf16(v0[0], v0[1]); w.y = cvt_pk_bf16(v0[2], v0[3]); w.z = cvt_pk_bf16(v1[0], v1[1]); w.w = cvt_pk_bf16(v1[2], v1[3]);
                    *(u32x4*)(rowp + bj * HALF) = w; } }
    }
};
struct EpiIn {
    static constexpr bool PERM = true, AFTER_DRAIN = false;
    bf16_t* O; int ldc; float* vstat;
    __device__ __forceinline__ void operator()(const f32x4 (&acc)[2][2][4][2], const Unit& u, int wr, int wc, int fr, int fq) const {
        const int mode = (u.pn >= 9 && u.pn < 12) ? 1 : ((u.pn >= 12 && u.pn < 15) ? 2 : 0);
        const int row0 = u.pm * BM + wr * 64 + fr, col0 = u.pn * BM + wc * 32 + 8 * fq;
#pragma unroll
        for (int ai = 0; ai < 2; ++ai)
#pragma unroll
            for (int m = 0; m < 4; ++m) { const int row = row0 + ai * HALF + m * 16; bf16_t* rowp = O + (size_t)row * ldc + col0; float s = 0.f, ss = 0.f;
#pragma unroll
                for (int bj = 0; bj < 2; ++bj) { f32x4 v0 = acc[ai][bj][m][0], v1 = acc[ai][bj][m][1];
                    if (mode) {
#pragma unroll
                        for (int j = 0; j < 4; ++j) { v0[j] = gelu_t(v0[j]); v1[j] = gelu_t(v1[j]); }
                        if (mode == 2) {
#pragma unroll
                            for (int j = 0; j < 4; ++j) { s += v0[j] + v1[j]; ss += v0[j] * v0[j] + v1[j] * v1[j]; } } }
                    u32x4 w; w.x = cvt_pk_bf16(v0[0], v0[1]); w.y = cvt_pk_bf16(v0[2], v0[3]); w.z = cvt_pk_bf16(v1[0], v1[1]); w.w = cvt_pk_bf16(v1[2], v1[3]);
                    *(u32x4*)(rowp + bj * HALF) = w; }
                if (mode == 2) { s += __shfl_xor(s, 16); s += __shfl_xor(s, 32); ss += __shfl_xor(ss, 16); ss += __shfl_xor(ss, 32);
                    if (fq == 0) *(f32x2*)(vstat + (size_t)row * 24 + ((u.pn - 12) * 4 + wc) * 2) = (f32x2){s, ss}; } }
    }
};
struct EpiMem {
    static constexpr bool PERM = true, AFTER_DRAIN = false;
    float* F; bf16_t* O;
    __device__ __forceinline__ void operator()(const f32x4 (&acc)[2][2][4][2], const Unit& u, int wr, int wc, int fr, int fq) const {
        const int row0 = u.pm * BM + wr * 64 + fr, col0 = u.pn * BM + wc * 32 + 8 * fq;
#pragma unroll
        for (int ai = 0; ai < 2; ++ai)
#pragma unroll
            for (int m = 0; m < 4; ++m) { const size_t off = (size_t)(row0 + ai * HALF + m * 16) * 1024 + col0;
#pragma unroll
                for (int bj = 0; bj < 2; ++bj) { const f32x4 v0 = acc[ai][bj][m][0], v1 = acc[ai][bj][m][1];
                    *(f32x4*)(F + off + bj * HALF) = v0; *(f32x4*)(F + off + bj * HALF + 4) = v1;
                    u32x4 w; w.x = cvt_pk_bf16(v0[0], v0[1]); w.y = cvt_pk_bf16(v0[2], v0[3]); w.z = cvt_pk_bf16(v1[0], v1[1]); w.w = cvt_pk_bf16(v1[2], v1[3]);
                    *(u32x4*)(O + off + bj * HALF) = w; } }
    }
};
struct EpiGate {
    static constexpr bool PERM = true, AFTER_DRAIN = false;
    const bf16_t* Hg; int ldh; const float* bg; bf16_t* MIX; int first;
    __device__ __forceinline__ void operator()(const f32x4 (&acc)[2][2][4][2], const Unit& u, int wr, int wc, int fr, int fq) const {
        const int row0 = u.pm * BM + wr * 64 + fr, col0 = u.pn * BM + wc * 32 + 8 * fq;
        f32x4 b0[2], b1[2];
#pragma unroll
        for (int bj = 0; bj < 2; ++bj) { b0[bj] = *(const f32x4*)(bg + col0 + bj * HALF); b1[bj] = *(const f32x4*)(bg + col0 + bj * HALF + 4); }
#pragma unroll
        for (int ai = 0; ai < 2; ++ai)
#pragma unroll
            for (int m = 0; m < 4; ++m) { const int row = row0 + ai * HALF + m * 16;
#pragma unroll
                for (int bj = 0; bj < 2; ++bj) { const int col = col0 + bj * HALF;
                    const u32x4 gw = *(const u32x4*)(Hg + (size_t)row * ldh + col);
                    f32x4 v0 = acc[ai][bj][m][0], v1 = acc[ai][bj][m][1];
                    v0[0] *= sigm(bflo(gw.x) + b0[bj][0]); v0[1] *= sigm(bfhi(gw.x) + b0[bj][1]); v0[2] *= sigm(bflo(gw.y) + b0[bj][2]); v0[3] *= sigm(bfhi(gw.y) + b0[bj][3]);
                    v1[0] *= sigm(bflo(gw.z) + b1[bj][0]); v1[1] *= sigm(bfhi(gw.z) + b1[bj][1]); v1[2] *= sigm(bflo(gw.w) + b1[bj][2]); v1[3] *= sigm(bfhi(gw.w) + b1[bj][3]);
                    u32x4* mp = (u32x4*)(MIX + (size_t)row * 1024 + col);
                    if (!first) { const u32x4 ow = *mp; v0[0] += bflo(ow.x); v0[1] += bfhi(ow.x); v0[2] += bflo(ow.y); v0[3] += bfhi(ow.y); v1[0] += bflo(ow.z); v1[1] += bfhi(ow.z); v1[2] += bflo(ow.w); v1[3] += bfhi(ow.w); }
                    u32x4 w; w.x = cvt_pk_bf16(v0[0], v0[1]); w.y = cvt_pk_bf16(v0[2], v0[3]); w.z = cvt_pk_bf16(v1[0], v1[1]); w.w = cvt_pk_bf16(v1[2], v1[3]);
                    *mp = w; }
                asm volatile("" ::: "memory"); }
    }
};

struct EpiConv {
    static constexpr bool PERM = true, AFTER_DRAIN = false;
    bf16_t* HH; const float* cw; const float* cb; float* convp; PG8_LAS float* halo;
    __device__ __forceinline__ void operator()(const f32x4 (&acc)[2][2][4][2], const Unit& u, int wr, int wc, int fr, int fq) const {
        const int lane = fr + 16 * fq, ch0 = u.pn * 128 + wc * 32 + 8 * fq;
        f32x4 cbv[2], w0[2], w1[2], w2[2];
#pragma unroll
        for (int n = 0; n < 2; ++n) { cbv[n] = *(const f32x4*)(cb + ch0 + 4 * n); w0[n] = *(const f32x4*)(cw + ch0 + 4 * n); w1[n] = *(const f32x4*)(cw + 2816 + ch0 + 4 * n); w2[n] = *(const f32x4*)(cw + 5632 + ch0 + 4 * n); }
        if (fr >= 14) {
#pragma unroll
            for (int ai = 0; ai < 2; ++ai)
#pragma unroll
                for (int n = 0; n < 2; ++n) *(PG8_LAS f32x4*)(halo + (((ai * 2 + wr) * 4 + wc) * 2 + (fr - 14)) * 32 + 8 * fq + 4 * n) = acc[ai][0][3][n]; }
        asm volatile("s_waitcnt lgkmcnt(0)" ::: "memory"); __builtin_amdgcn_s_barrier(); asm volatile("" ::: "memory");
        const int src1 = (fr == 0) ? lane + 15 : lane - 1, src2 = (fr < 2) ? lane + 14 : lane - 2;
#pragma unroll
        for (int ai = 0; ai < 2; ++ai) {
            f32x4 hprev[2] = {{0.f, 0.f, 0.f, 0.f}, {0.f, 0.f, 0.f, 0.f}};
            const int pb = ai * 2 + wr - 1;
            if (fr >= 14 && pb >= 0) {
#pragma unroll
                for (int n = 0; n < 2; ++n) hprev[n] = *(const PG8_LAS f32x4*)(halo + ((pb * 4 + wc) * 2 + (fr - 14)) * 32 + 8 * fq + 4 * n); }
#pragma unroll
            for (int m = 0; m < 4; ++m) { const int rt = ai * HALF + wr * 64 + m * 16 + fr; const long grow = (long)u.pm * 254 - 2 + rt;
                u32x4 w; unsigned pk[4];
#pragma unroll
                for (int n = 0; n < 2; ++n) { const f32x4 cur = acc[ai][0][m][n], prv = (m == 0) ? hprev[n] : acc[ai][0][m == 0 ? 0 : m - 1][n], vv = acc[ai][1][m][n]; float hv[4];
#pragma unroll
                    for (int j = 0; j < 4; ++j) { const float s1 = (fr == 15) ? prv[j] : cur[j], s2 = (fr >= 14) ? prv[j] : cur[j];
                        const float p1 = __shfl(s1, src1), p2 = __shfl(s2, src2);
                        const float cv = cbv[n][j] + w0[n][j] * p2 + w1[n][j] * p1 + w2[n][j] * cur[j]; hv[j] = gelu_t(cv) * vv[j]; }
                    pk[2 * n] = cvt_pk_bf16(hv[0], hv[1]); pk[2 * n + 1] = cvt_pk_bf16(hv[2], hv[3]); }
                w.x = pk[0]; w.y = pk[1]; w.z = pk[2]; w.w = pk[3];
                if (rt >= 2 && grow < 16384) { *(u32x4*)(HH + (size_t)grow * 2816 + ch0) = w;
                    if (grow >= 16382) { float* op = convp + (size_t)(grow - 16382) * 2816 + ch0; *(f32x4*)op = acc[ai][0][m][0]; *(f32x4*)(op + 4) = acc[ai][0][m][1]; } }
                __builtin_amdgcn_sched_barrier(0); } }
    }
};
struct EpiRes {
    static constexpr bool PERM = false, AFTER_DRAIN = false;
    const float* res; float* out; float alpha;
    __device__ __forceinline__ void operator()(const f32x4 (&acc)[2][2][4][2], const Unit& u, int wr, int wc, int fr, int fq) const {
        const int row0 = u.pm * BM + wr * 64 + fr, col0 = u.pn * BM + wc * 32 + 4 * fq;
#pragma unroll
        for (int ai = 0; ai < 2; ++ai)
#pragma unroll
            for (int m = 0; m < 4; ++m) { const size_t off = (size_t)(row0 + ai * HALF + m * 16) * 1024 + col0;
#pragma unroll
                for (int bj = 0; bj < 2; ++bj)
#pragma unroll
                    for (int n = 0; n < 2; ++n) { const f32x4 r = *(const f32x4*)(res + off + bj * HALF + n * 16); *(f32x4*)(out + off + bj * HALF + n * 16) = r * alpha + acc[ai][bj][m][n]; }
                if (m & 1) asm volatile("" ::: "memory"); }
    }
};

template <class Epi, class Sched, bool ALIGN_EPI = false, bool SP2 = false>
__device__ __forceinline__ void gemm_phase(PG8_LAS unsigned char* lds, const Gemm g, const Sched& S, const Epi& E) {
    int tid_ = threadIdx.x; asm volatile("" : "+v"(tid_));
    const int tid = tid_, wid = __builtin_amdgcn_readfirstlane(tid >> 6), lane = tid & 63, wr = wid >> 2, wc = wid & 3, fr = lane & 15, fq = lane >> 4;
    const int K = g.K, nt = K / BK;
    unsigned voffA[2], voffB[2];
#pragma unroll
    for (int i = 0; i < 2; ++i) { int R, C; stage_rc(tid * 16 + i * 8192, R, C); const int Rb = Epi::PERM ? ((R & ~31) + perm32(R & 31)) : R;
        voffA[i] = (unsigned)(R * K + C) * 2u; voffB[i] = (unsigned)(Rb * K + C) * 2u; }
    const size_t kstep = (size_t)(BK * 2);
    const size_t hstep = (size_t)HALF * K * 2;
    const size_t tstep = 2 * hstep;
    const size_t pstepA = g.pstepA ? g.pstepA : tstep;
    const unsigned ldsw = (unsigned)wid * 1024u;
    const int aoff = lds_byte(wr * 64 + fr, fq * 8), boff = lds_byte(wc * 32 + fr, fq * 8);
#define PG8_SA(b, h) (((b) * 2 + (h)) * HTB)
#define PG8_SB(b, h) ((4 + (b) * 2 + (h)) * HTB)
#define PG8_STAGE(bufoff, gbase, voff) do { _Pragma("unroll") for (int _i = 0; _i < 2; ++_i) \
        __builtin_amdgcn_global_load_lds((const unsigned*)((const char*)(gbase) + (voff)[_i]), (PG8_LAS unsigned*)(lds + (bufoff) + ldsw + _i * 8192), 16, 0, 0); } while (0)
#define PG8_LDA(dst, b, h) do { _Pragma("unroll") for (int m = 0; m < 4; ++m) _Pragma("unroll") for (int k = 0; k < 2; ++k) dst[m][k] = *(const PG8_LAS bf16x8*)(lds + PG8_SA(b, h) + aoff + m * 2048 + k * 1024); } while (0)
#define PG8_LDB(dst, b, h) do { _Pragma("unroll") for (int n = 0; n < 2; ++n) _Pragma("unroll") for (int k = 0; k < 2; ++k) dst[n][k] = *(const PG8_LAS bf16x8*)(lds + PG8_SB(b, h) + boff + n * 2048 + k * 1024); } while (0)
#define PG8_MMA(ai, bj, At, Bt) do { __builtin_amdgcn_s_setprio(1); _Pragma("unroll") for (int m = 0; m < 4; ++m) _Pragma("unroll") for (int n = 0; n < 2; ++n) _Pragma("unroll") for (int k = 0; k < 2; ++k) \
        acc[ai][bj][m][n] = __builtin_amdgcn_mfma_f32_16x16x32_bf16(Bt[n][k], At[m][k], acc[ai][bj][m][n], 0, 0, 0); __builtin_amdgcn_s_setprio(0); } while (0)
#define PG8_WAIT_V(n) asm volatile("s_waitcnt vmcnt(" #n ")" ::: "memory")
#define PG8_WAIT_L(n) asm volatile("s_waitcnt lgkmcnt(" #n ")" ::: "memory")
#define PG8_BAR __builtin_amdgcn_s_barrier()
#define PG8_SCHED __builtin_amdgcn_sched_barrier(0)
    Unit cur, nxt; int ui = 0;
    if (!S.next(0, cur)) return;
    f32x4 acc[2][2][4][2];
#pragma unroll
    for (int a = 0; a < 2; ++a)
#pragma unroll
        for (int b = 0; b < 2; ++b)
#pragma unroll
            for (int m = 0; m < 4; ++m)
#pragma unroll
                for (int n = 0; n < 2; ++n) acc[a][b][m][n] = (f32x4){0.f, 0.f, 0.f, 0.f};
    bf16x8 At[4][2], B0[2][2], B1[2][2];
    const char* cA = (const char*)g.A + (size_t)cur.pm * pstepA; const char* cB = (const char*)g.Bt + (size_t)cur.pn * tstep;
    S.a_ready(cur);
    if constexpr (SP2) {
        PG8_STAGE(PG8_SB(0, 0), cB, voffB); PG8_STAGE(PG8_SB(0, 1), cB + hstep, voffB); PG8_STAGE(PG8_SA(0, 0), cA, voffA); PG8_STAGE(PG8_SA(0, 1), cA + hstep, voffA);
        if (wr == 1) PG8_BAR;
        PG8_WAIT_V(2); PG8_BAR;
        PG8_STAGE(PG8_SB(1, 0), cB + kstep, voffB); PG8_STAGE(PG8_SA(1, 0), cA + kstep, voffA); PG8_STAGE(PG8_SB(1, 1), cB + hstep + kstep, voffB);
        PG8_WAIT_V(6); PG8_BAR;
    } else {
        PG8_STAGE(PG8_SB(0, 0), cB, voffB); PG8_STAGE(PG8_SA(0, 0), cA, voffA); PG8_STAGE(PG8_SB(0, 1), cB + hstep, voffB); PG8_STAGE(PG8_SA(0, 1), cA + hstep, voffA);
        if (wr == 1) PG8_BAR;
        PG8_WAIT_V(4); PG8_BAR;
        PG8_STAGE(PG8_SB(1, 0), cB + kstep, voffB); PG8_STAGE(PG8_SA(1, 0), cA + kstep, voffA); PG8_STAGE(PG8_SB(1, 1), cB + hstep + kstep, voffB);
        PG8_WAIT_V(6); PG8_BAR;
    }
    for (;;) {
        const bool has_next = S.next(ui + 1, nxt);
        const char* nA = has_next ? (const char*)g.A + (size_t)nxt.pm * pstepA : cA; const char* nB = has_next ? (const char*)g.Bt + (size_t)nxt.pn * tstep : cB;
        for (int t = 0; t < nt; t += 2) {
            const bool last = (t == nt - 2);
            const char* a1 = cA + (size_t)(t + 1) * kstep;
            const char* a2 = last ? nA : cA + (size_t)(t + 2) * kstep; const char* b2 = last ? nB : cB + (size_t)(t + 2) * kstep;
            const char* a3 = a2 + kstep; const char* b3 = b2 + kstep;
            if (last && has_next) S.a_ready(nxt);
            if constexpr (SP2) {
            PG8_LDB(B0, 0, 0); PG8_LDB(B1, 0, 1); PG8_SCHED; PG8_LDA(At, 0, 0); PG8_STAGE(PG8_SA(1, 1), a1 + hstep, voffA);
            PG8_WAIT_V(8); PG8_WAIT_L(0); PG8_BAR; PG8_MMA(0, 0, At, B0); PG8_MMA(0, 1, At, B1); PG8_BAR; PG8_SCHED;
            PG8_LDA(At, 0, 1); PG8_STAGE(PG8_SB(0, 0), b2, voffB); PG8_STAGE(PG8_SB(0, 1), b2 + hstep, voffB); PG8_STAGE(PG8_SA(0, 0), a2, voffA);
            PG8_WAIT_V(8); PG8_WAIT_L(0); PG8_BAR; PG8_MMA(1, 0, At, B0); PG8_MMA(1, 1, At, B1); PG8_BAR; PG8_SCHED;
            PG8_LDB(B0, 1, 0); PG8_LDB(B1, 1, 1); PG8_SCHED; PG8_LDA(At, 1, 0); PG8_STAGE(PG8_SA(0, 1), a2 + hstep, voffA);
            PG8_WAIT_V(8); PG8_WAIT_L(0); PG8_BAR; PG8_MMA(0, 0, At, B0); PG8_MMA(0, 1, At, B1); PG8_BAR; PG8_SCHED;
            PG8_LDA(At, 1, 1); PG8_STAGE(PG8_SB(1, 0), b3, voffB); PG8_STAGE(PG8_SB(1, 1), b3 + hstep, voffB); PG8_STAGE(PG8_SA(1, 0), a3, voffA);
            PG8_WAIT_V(8); PG8_WAIT_L(0); PG8_BAR; PG8_MMA(1, 0, At, B0); PG8_MMA(1, 1, At, B1); PG8_BAR; PG8_SCHED;
            } else {
            PG8_LDB(B0, 0, 0); PG8_SCHED; PG8_LDA(At, 0, 0); PG8_STAGE(PG8_SA(1, 1), a1 + hstep, voffA);
            PG8_WAIT_L(8); PG8_BAR; PG8_WAIT_L(0); PG8_MMA(0, 0, At, B0); PG8_BAR; PG8_SCHED;
            PG8_LDB(B1, 0, 1); PG8_STAGE(PG8_SB(0, 0), b2, voffB);
            PG8_BAR; PG8_WAIT_L(0); PG8_MMA(0, 1, At, B1); PG8_BAR;
            PG8_LDA(At, 0, 1); PG8_STAGE(PG8_SA(0, 0), a2, voffA);
            PG8_BAR; PG8_WAIT_L(0); PG8_MMA(1, 0, At, B0); PG8_BAR; PG8_SCHED;
            PG8_STAGE(PG8_SB(0, 1), b2 + hstep, voffB);
            PG8_WAIT_V(6); PG8_BAR; PG8_MMA(1, 1, At, B1); PG8_BAR;
            PG8_LDB(B0, 1, 0); PG8_SCHED; PG8_LDA(At, 1, 0); PG8_STAGE(PG8_SA(0, 1), a2 + hstep, voffA);
            PG8_WAIT_L(8); PG8_BAR; PG8_WAIT_L(0); PG8_MMA(0, 0, At, B0); PG8_BAR; PG8_SCHED;
            PG8_LDB(B1, 1, 1); PG8_STAGE(PG8_SB(1, 0), b3, voffB);
            PG8_BAR; PG8_WAIT_L(0); PG8_MMA(0, 1, At, B1); PG8_BAR;
            PG8_LDA(At, 1, 1); PG8_STAGE(PG8_SA(1, 0), a3, voffA);
            PG8_BAR; PG8_WAIT_L(0); PG8_MMA(1, 0, At, B0); PG8_BAR; PG8_SCHED;
            PG8_STAGE(PG8_SB(1, 1), b3 + hstep, voffB);
            PG8_WAIT_V(6); PG8_BAR; PG8_MMA(1, 1, At, B1); PG8_BAR;
            }
        }
        if constexpr (ALIGN_EPI) { if (wr == 0) PG8_BAR; }
        if constexpr (!Epi::AFTER_DRAIN) { E(acc, cur, wr, wc, fr, fq); S.done(cur); }
        if (!has_next) break;
#pragma unroll
        for (int a = 0; a < 2; ++a)
#pragma unroll
            for (int b = 0; b < 2; ++b)
#pragma unroll
                for (int m = 0; m < 4; ++m)
#pragma unroll
                    for (int n = 0; n < 2; ++n) acc[a][b][m][n] = (f32x4){0.f, 0.f, 0.f, 0.f};
        cur = nxt; cA = nA; cB = nB; ++ui;
        if constexpr (ALIGN_EPI) { if (wr == 1) PG8_BAR; }
    }
    PG8_WAIT_V(0);
    if constexpr (!ALIGN_EPI) { if (wr == 0) PG8_BAR; }
    PG8_BAR;
    if constexpr (Epi::AFTER_DRAIN) { E.fused(acc, cur, wr, wc, fr, fq, lds, wid, lane); S.done(cur); }
#undef PG8_SA
#undef PG8_SB
#undef PG8_STAGE
#undef PG8_LDA
#undef PG8_LDB
#undef PG8_MMA
#undef PG8_WAIT_V
#undef PG8_WAIT_L
#undef PG8_BAR
#undef PG8_SCHED
}
}

using pg8::bf16_t; using pg8::bf16x8; using pg8::f32x4; using pg8::u32x4;
using pg8::cvt_pk_bf16; using pg8::bflo; using pg8::bfhi; using pg8::bf2f; using pg8::f2bf; using pg8::gelu_t; using pg8::sigm;
#define LAS __attribute__((address_space(3)))
typedef unsigned u32x2 __attribute__((ext_vector_type(2)));
using pg8::f32x2;

constexpr int SQ = 16384, NSMP = 32, MV = SQ + NSMP, DM = 1024, INW = 7424, DFF = 2816, NMEM = 256;
constexpr int C_QA = 0, C_KA = 768, C_VA = 1536, C_UB = 2304, C_VB = 3072, C_QM = 3840, C_GT = 4352;
constexpr float ALPHA = 1.189207115002721f, LN_EPS = 1e-5f;
constexpr size_t O_YP = 0, O_YS = 16777216, O_W128P = 16809984, O_W512P = 16875520, O_W2048P = 17137664, O_MEMP = 18186240, O_CONVP = 18448384,
                 O_W128S = 18454016, O_W512S = 18470400, O_W2048S = 18486784, O_GV = 18503168, O_CONVS = 18527744, O_END = 18707968;
constexpr size_t MiB = 1u << 20;
constexpr size_t WS_BAR = 512 * 1024;
constexpr size_t WS_VSTAT = 488 * MiB, WS_WIN = 1 * MiB, WS_WMEM = 16 * MiB, WS_WBA = 18 * MiB, WS_WBB = 19 * MiB, WS_WBM = 21 * MiB, WS_WOUT = 22 * MiB, WS_WUP = 24 * MiB,
                 WS_WDOWN = 35 * MiB, WS_WSB = 41 * MiB, WS_MEMB = 42 * MiB, WS_MKV = 43 * MiB, WS_XB = 44 * MiB, WS_H = 77 * MiB, WS_OG = 313 * MiB, WS_LSE = 338 * MiB,
                 WS_OA = 339 * MiB, WS_OB = 348 * MiB, WS_OM = 373 * MiB, WS_MIX = 390 * MiB, WS_Z1 = 423 * MiB, WS_END = 490 * MiB;
constexpr size_t WS_U = WS_H, WS_HH = WS_OG, WS_X1B = WS_XB;
static_assert(WS_XB + (size_t)MV * DM * 2 <= WS_H && WS_H + (size_t)MV * INW * 2 <= WS_OG && WS_OG + (size_t)3 * MV * 256 * 2 <= WS_LSE && WS_LSE + (size_t)3 * MV * 16 <= WS_OA, "ws map 1");
static_assert(WS_OA + (size_t)MV * 512 <= WS_OB && WS_OB + (size_t)MV * 1536 <= WS_OM && WS_OM + (size_t)MV * 1024 <= WS_MIX && WS_MIX + (size_t)MV * 2048 <= WS_Z1 && WS_Z1 + (size_t)MV * 4096 <= WS_VSTAT && WS_VSTAT + (size_t)MV * 96 <= WS_END, "ws map 2");
static_assert(WS_U + (size_t)MV * 2 * DFF * 2 <= WS_OG && WS_HH + (size_t)MV * DFF * 2 <= WS_Z1, "ws map 3");
static_assert(WS_WIN + (size_t)INW * DM * 2 <= WS_WMEM && WS_WUP + (size_t)2 * DFF * DM * 2 <= WS_WDOWN && WS_WDOWN + (size_t)DM * DFF * 2 <= WS_WSB, "ws map 4");
constexpr int LDS_BYTES = 147456;

struct Args { const float* in[27]; float* out; unsigned char* ws; };

__device__ __forceinline__ float wave_sum(float v) {
#pragma unroll
    for (int o = 1; o < 64; o <<= 1) v += __shfl_xor(v, o);
    return v;
}
__device__ __forceinline__ float wave_max(float v) {
#pragma unroll
    for (int o = 1; o < 64; o <<= 1) v = fmaxf(v, __shfl_xor(v, o));
    return v;
}
#define LDS_WAIT() asm volatile("s_waitcnt lgkmcnt(0)" ::: "memory")

__device__ __forceinline__ void p0_transpose_item(const float* W, int K, int N, bf16_t* WT, LAS float* scr, int item, int lane, bool ilv) {
    const int nblk = N / 32, kb = item / nblk, nb = item % nblk, k0 = 64 * kb, n0 = 32 * nb;
    const int d0 = !ilv ? n0 : (n0 < 2816 ? 256 * (n0 >> 7) + (n0 & 127) : 256 * ((n0 - 2816) >> 7) + 128 + ((n0 - 2816) & 127));
#pragma unroll 8
    for (int i = 0; i < 32; ++i) { const int kk = 2 * i + (lane >> 5); scr[kk * 33 + (lane & 31)] = W[(size_t)(k0 + kk) * N + n0 + (lane & 31)]; }
    LDS_WAIT(); asm volatile("" ::: "memory");
    const int c = lane & 7;
#pragma unroll
    for (int j = 0; j < 4; ++j) { const int n = (lane >> 3) + 8 * j; const LAS float* s = scr + (8 * c) * 33 + n;
        u32x4 o; o.x = cvt_pk_bf16(s[0 * 33], s[1 * 33]); o.y = cvt_pk_bf16(s[2 * 33], s[3 * 33]); o.z = cvt_pk_bf16(s[4 * 33], s[5 * 33]); o.w = cvt_pk_bf16(s[6 * 33], s[7 * 33]);
        *(u32x4*)(WT + (size_t)(d0 + n) * K + k0 + 8 * c) = o; }
    LDS_WAIT(); asm volatile("" ::: "memory");
}
__device__ __forceinline__ void cast_bf16(const float* src, bf16_t* dst, size_t n8, size_t gt, size_t GT) {
    for (size_t i = gt; i < n8; i += GT) { const f32x4 a = *(const f32x4*)(src + i * 8), b = *(const f32x4*)(src + i * 8 + 4);
        u32x4 w; w.x = cvt_pk_bf16(a[0], a[1]); w.y = cvt_pk_bf16(a[2], a[3]); w.z = cvt_pk_bf16(b[0], b[1]); w.w = cvt_pk_bf16(b[2], b[3]); *(u32x4*)(dst + i * 8) = w; }
}
__device__ __forceinline__ void p0_prologue(const Args& a, LAS unsigned char* lds, int tid, int wid, int lane) {
    unsigned char* ws = a.ws;
    LAS float* scr = (LAS float*)(lds + wid * 16384);
    const int gw = blockIdx.x * 8 + wid, NGW = gridDim.x * 8;
    const float* Wsrc[8] = {a.in[8], a.in[14], a.in[15], a.in[16], a.in[17], a.in[18], a.in[21], a.in[24]};
    const int Ks[8] = {DM, DM, 256, 768, 512, DM, DM, DFF}, Ns[8] = {INW, 1024, DM, DM, DM, DM, 2 * DFF, DM};
    const size_t Wo[8] = {WS_WIN, WS_WMEM, WS_WBA, WS_WBB, WS_WBM, WS_WOUT, WS_WUP, WS_WDOWN};
    int base = 0;
#pragma unroll
    for (int w = 0; w < 8; ++w) { const int items = (Ks[w] / 64) * (Ns[w] / 32);
        int first = (gw - base % NGW + NGW) % NGW;
        for (int it = first; it < items; it += NGW) p0_transpose_item(Wsrc[w], Ks[w], Ns[w], (bf16_t*)(ws + Wo[w]), scr, it, lane, w == 6);
        base += items; }
    const size_t gt = (size_t)blockIdx.x * 512 + tid, GT = (size_t)gridDim.x * 512;
    cast_bf16(a.in[0], (bf16_t*)(ws + WS_XB), (size_t)SQ * DM / 8, gt, GT);
    cast_bf16(a.in[1], (bf16_t*)(ws + WS_XB) + (size_t)SQ * DM, (size_t)NSMP * DM / 8, gt, GT);
    cast_bf16(a.in[2], (bf16_t*)(ws + WS_MEMB), (size_t)NMEM * DM / 8, gt, GT);
    for (size_t i = gt; i < 4096 / 16; i += GT) *(u32x4*)(ws + WS_X1B - 4096 + i * 16) = (u32x4){0u, 0u, 0u, 0u};
    { bf16_t* wsb = (bf16_t*)(ws + WS_WSB); const float* wsp = a.in[12];
      for (size_t i = gt; i < 4 * 128 * 128; i += GT) { const int r = (int)(i >> 7) & 127, c = (int)i & 127; wsb[i] = f2bf(c <= r ? wsp[i] : 0.f); } }
}

__device__ __forceinline__ float sgemm_item(const bf16_t* A, const bf16_t* Bt, int K, int n0, LAS float* red, int tid, int wid, int lane) {
    const int fr = lane & 15, fq = lane >> 4, kw = K >> 3, nks = kw >> 5;
    const bf16_t* ap = A + (size_t)fr * K + wid * kw + 8 * fq; const bf16_t* bp = Bt + (size_t)(n0 + fr) * K + wid * kw + 8 * fq;
    f32x4 c0 = {0.f, 0.f, 0.f, 0.f}, c1 = {0.f, 0.f, 0.f, 0.f};
    int ks = 0;
    for (; ks + 4 <= nks; ks += 4) { bf16x8 b[4], a0[4], a1[4];
#pragma unroll
        for (int j = 0; j < 4; ++j) { b[j] = *(const bf16x8*)(bp + 32 * (ks + j)); a0[j] = *(const bf16x8*)(ap + 32 * (ks + j)); a1[j] = *(const bf16x8*)(ap + (size_t)16 * K + 32 * (ks + j)); }
#pragma unroll
        for (int j = 0; j < 4; ++j) { c0 = __builtin_amdgcn_mfma_f32_16x16x32_bf16(b[j], a0[j], c0, 0, 0, 0); c1 = __builtin_amdgcn_mfma_f32_16x16x32_bf16(b[j], a1[j], c1, 0, 0, 0); } }
    for (; ks < nks; ++ks) { const bf16x8 b = *(const bf16x8*)(bp + 32 * ks), a0 = *(const bf16x8*)(ap + 32 * ks), a1 = *(const bf16x8*)(ap + (size_t)16 * K + 32 * ks);
        c0 = __builtin_amdgcn_mfma_f32_16x16x32_bf16(b, a0, c0, 0, 0, 0); c1 = __builtin_amdgcn_mfma_f32_16x16x32_bf16(b, a1, c1, 0, 0, 0); }
    *(LAS f32x4*)(red + wid * 512 + fr * 16 + 4 * fq) = c0; *(LAS f32x4*)(red + wid * 512 + (16 + fr) * 16 + 4 * fq) = c1;
    __syncthreads();
    float s = 0.f;
#pragma unroll
    for (int w = 0; w < 8; ++w) s += red[w * 512 + tid];
    __syncthreads();
    return s;
}

__device__ __forceinline__ void attn_tile(const bf16_t* H, bf16_t* OG, float* LSE, int T, LAS unsigned char* lds, int tid, int wid, int lane) {
    const int fr = lane & 15, fq = lane >> 4;
    const int g = T >> 9, idx = T & 511, h = idx & 3, rr = idx >> 2, dsh = 2 * g, d = 1 << dsh, n = rr >> dsh, r = rr & (d - 1);
    const int colq = (g * 4 + h) * 64, colk = C_KA + colq, colv = C_VA + colq;
    LAS unsigned char* Ks = lds;
    LAS unsigned char* VT = lds + 36864;
#pragma unroll
    for (int it = 0; it < 4; ++it) { const int p = tid + 512 * it, key = p >> 3, ch = p & 7, kidx = (n - 1) * 128 + key;
        u32x4 v = {0u, 0u, 0u, 0u}; if (kidx >= 0) v = *(const u32x4*)(H + (size_t)(kidx * d + r) * INW + colk + ch * 8);
        *(LAS u32x4*)(Ks + key * 144 + ch * 16) = v; }
#pragma unroll
    for (int it = 0; it < 4; ++it) { const int key = it * 64 + lane, kidx = (n - 1) * 128 + key;
        u32x4 v = {0u, 0u, 0u, 0u}; if (kidx >= 0) v = *(const u32x4*)(H + (size_t)(kidx * d + r) * INW + colv + wid * 8);
        LAS unsigned short* vp = (LAS unsigned short*)(VT + (wid * 8) * 544 + key * 2);
        vp[0 * 272] = (unsigned short)(v.x & 0xffffu); vp[1 * 272] = (unsigned short)(v.x >> 16); vp[2 * 272] = (unsigned short)(v.y & 0xffffu); vp[3 * 272] = (unsigned short)(v.y >> 16);
        vp[4 * 272] = (unsigned short)(v.z & 0xffffu); vp[5 * 272] = (unsigned short)(v.z >> 16); vp[6 * 272] = (unsigned short)(v.w & 0xffffu); vp[7 * 272] = (unsigned short)(v.w >> 16); }
    if (tid < 128) *(LAS u32x4*)(VT + (tid >> 1) * 544 + 512 + (tid & 1) * 16) = (u32x4){0u, 0u, 0u, 0u};
    const int pos = ((n * 128 + 16 * wid + fr) << dsh) + r;
    bf16x8 qf[2];
#pragma unroll
    for (int ks = 0; ks < 2; ++ks) qf[ks] = *(const bf16x8*)(H + (size_t)pos * INW + colq + 8 * fq + 32 * ks);
    __syncthreads();
    f32x4 s[9];
#pragma unroll
    for (int t = 0; t < 9; ++t) { f32x4 acc = {0.f, 0.f, 0.f, 0.f};
#pragma unroll
        for (int ks = 0; ks < 2; ++ks) { const bf16x8 kf = *(const LAS bf16x8*)(Ks + (16 * (wid + t) + fr) * 144 + (8 * fq + 32 * ks) * 2); acc = __builtin_amdgcn_mfma_f32_16x16x32_bf16(kf, qf[ks], acc, 0, 0, 0); }
        s[t] = acc; }
    float mx = -1e30f;
#pragma unroll
    for (int t = 0; t < 9; ++t) { const bool blk_ok = (n > 0) || (wid + t >= 8);
#pragma unroll
        for (int i = 0; i < 4; ++i) { const int jj = 4 * fq + i; bool ok = blk_ok; if (t == 0) ok = ok && (jj >= fr); if (t == 8) ok = ok && (jj <= fr);
            const float v = ok ? s[t][i] : -1e30f; s[t][i] = v; mx = fmaxf(mx, v); } }
    mx = fmaxf(mx, __shfl_xor(mx, 16)); mx = fmaxf(mx, __shfl_xor(mx, 32));
    const float cs = 0.125f * 1.44269504f; float sum = 0.f;
#pragma unroll
    for (int t = 0; t < 9; ++t)
#pragma unroll
        for (int i = 0; i < 4; ++i) { const float p = __builtin_amdgcn_exp2f((s[t][i] - mx) * cs); s[t][i] = p; sum += p; }
    sum += __shfl_xor(sum, 16); sum += __shfl_xor(sum, 32);
    f32x4 o[4];
#pragma unroll
    for (int eb = 0; eb < 4; ++eb) o[eb] = (f32x4){0.f, 0.f, 0.f, 0.f};
#pragma unroll
    for (int c5 = 0; c5 < 5; ++c5) { const int t0 = 2 * c5, t1 = t0 + 1;
        u32x4 pw; pw.x = cvt_pk_bf16(s[t0][0], s[t0][1]); pw.y = cvt_pk_bf16(s[t0][2], s[t0][3]);
        if (t1 < 9) { pw.z = cvt_pk_bf16(s[t1 < 9 ? t1 : 0][0], s[t1 < 9 ? t1 : 0][1]); pw.w = cvt_pk_bf16(s[t1 < 9 ? t1 : 0][2], s[t1 < 9 ? t1 : 0][3]); } else { pw.z = 0u; pw.w = 0u; }
        const bf16x8 pf = __builtin_bit_cast(bf16x8, pw);
#pragma unroll
        for (int eb = 0; eb < 4; ++eb) { const LAS unsigned char* vp = VT + (16 * eb + fr) * 544 + (16 * (wid + t0) + 4 * fq) * 2;
            const u32x2 lo = *(const LAS u32x2*)vp, hi = *(const LAS u32x2*)(vp + 32);
            const u32x4 vw = {lo.x, lo.y, hi.x, hi.y};
            o[eb] = __builtin_amdgcn_mfma_f32_16x16x32_bf16(__builtin_bit_cast(bf16x8, vw), pf, o[eb], 0, 0, 0); } }
    const float inv = 1.0f / sum;
    bf16_t* op = OG + ((size_t)g * MV + pos) * 256 + h * 64 + 4 * fq;
#pragma unroll
    for (int eb = 0; eb < 4; ++eb) { u32x2 w; w.x = cvt_pk_bf16(o[eb][0] * inv, o[eb][1] * inv); w.y = cvt_pk_bf16(o[eb][2] * inv, o[eb][3] * inv); *(u32x2*)(op + 16 * eb) = w; }
    if (fq == 0) LSE[((size_t)g * MV + pos) * 4 + h] = mx * 0.125f + __builtin_amdgcn_logf(sum) * 0.69314718f;
    __syncthreads();
}

__device__ __forceinline__ void sattn_wg(const Args& a, const bf16_t* H, bf16_t* OA, int item, LAS float* sm, int tid, int wid, int lane) {
    const int b = item >> 2, h = item & 3; const size_t row = SQ + b;
    LAS float* qs = sm; LAS float* wmaxs = sm + 64; LAS float* wsums = sm + 80; LAS float* part = sm + 256;
    float og[3] = {0.f, 0.f, 0.f}, lg[3] = {0.f, 0.f, 0.f};
#pragma unroll
    for (int g = 0; g < 3; ++g) { const int d = 1 << (2 * g), Wb = 128 * d; const float* cache = a.in[3 + g]; const int colq = (g * 4 + h) * 64;
        const float qe = bf2f(H[row * INW + colq + lane]), kn = bf2f(H[row * INW + C_KA + colq + lane]);
        if (tid < 64) qs[tid] = qe;
        __syncthreads();
        const float s_new = wave_sum(qe * kn) * 0.125f;
        const int kl = lane >> 2, q4 = lane & 3, kk = 1 + wid * 16 + kl, ix = Wb - kk * d;
        const float* kp = cache + (((size_t)b * Wb + ix) * 2 + 0) * 256 + h * 64 + q4 * 16; float dot = 0.f;
#pragma unroll
        for (int e = 0; e < 16; e += 4) { const f32x4 k4 = *(const f32x4*)(kp + e); const f32x4 x4 = *(const LAS f32x4*)(qs + q4 * 16 + e); dot += k4[0] * x4[0] + k4[1] * x4[1] + k4[2] * x4[2] + k4[3] * x4[3]; }
        dot += __shfl_xor(dot, 1); dot += __shfl_xor(dot, 2);
        const float sc = dot * 0.125f;
        const float wm = wave_max(sc); if (lane == 0) wmaxs[wid] = wm;
        __syncthreads();
        float mx = s_new;
#pragma unroll
        for (int w = 0; w < 8; ++w) mx = fmaxf(mx, wmaxs[w]);
        const float p = __expf(sc - mx), pn = __expf(s_new - mx);
        const float psum = wave_sum(p) * 0.25f;
        const int e16 = lane & 15, kq = lane >> 4; f32x4 acc = {0.f, 0.f, 0.f, 0.f};
#pragma unroll
        for (int j = 0; j < 4; ++j) { const int kloc = kq * 4 + j; const float pk = __shfl(p, 4 * kloc); const int ix2 = Wb - (1 + wid * 16 + kloc) * d;
            const f32x4 v4 = *(const f32x4*)(cache + (((size_t)b * Wb + ix2) * 2 + 1) * 256 + h * 64 + e16 * 4); acc = acc + v4 * pk; }
#pragma unroll
        for (int j = 0; j < 4; ++j) { acc[j] += __shfl_xor(acc[j], 16); acc[j] += __shfl_xor(acc[j], 32); }
        if (lane < 16) *(LAS f32x4*)(part + wid * 64 + e16 * 4) = acc;
        if (lane == 0) wsums[wid] = psum;
        __syncthreads();
        if (tid < 64) { float o = pn * bf2f(H[row * INW + C_VA + colq + tid]), sum = pn;
#pragma unroll
            for (int w = 0; w < 8; ++w) { o += part[w * 64 + tid]; sum += wsums[w]; }
            og[g] = o / sum; lg[g] = mx + __logf(sum); }
        __syncthreads(); }
    if (tid < 64) { const float m = fmaxf(lg[0], fmaxf(lg[1], lg[2])); const float w0 = __expf(lg[0] - m), w1 = __expf(lg[1] - m), w2 = __expf(lg[2] - m);
        OA[row * 256 + h * 64 + tid] = f2bf((w0 * og[0] + w1 * og[1] + w2 * og[2]) / (w0 + w1 + w2)); }
}

__device__ __forceinline__ void mem_load_kv(const bf16_t* MKV, int h, LAS unsigned char* lds, int tid, int wid, int lane) {
    LAS unsigned char* Km = lds;
    LAS unsigned char* VT = lds + 69632;
#pragma unroll
    for (int it = 0; it < 8; ++it) { const int p = tid + 512 * it, key = p >> 4, ch = p & 15;
        *(LAS u32x4*)(Km + key * 272 + ch * 16) = *(const u32x4*)(MKV + (size_t)key * 1024 + h * 128 + ch * 8); }
#pragma unroll
    for (int it = 0; it < 8; ++it) { const int key = (it & 3) * 64 + lane, ch = wid + 8 * (it >> 2);
        const u32x4 v = *(const u32x4*)(MKV + (size_t)key * 1024 + 512 + h * 128 + ch * 8);
        LAS unsigned short* vp = (LAS unsigned short*)(VT + (ch * 8) * 544 + key * 2);
        vp[0 * 272] = (unsigned short)(v.x & 0xffffu); vp[1 * 272] = (unsigned short)(v.x >> 16); vp[2 * 272] = (unsigned short)(v.y & 0xffffu); vp[3 * 272] = (unsigned short)(v.y >> 16);
        vp[4 * 272] = (unsigned short)(v.z & 0xffffu); vp[5 * 272] = (unsigned short)(v.z >> 16); vp[6 * 272] = (unsigned short)(v.w & 0xffffu); vp[7 * 272] = (unsigned short)(v.w >> 16); }
    __syncthreads();
}
__device__ __forceinline__ void mem_tile(const bf16_t* H, bf16_t* OM, int h, int tile, LAS unsigned char* lds, int wid, int lane) {
    const int fr = lane & 15, fq = lane >> 4;
    const LAS unsigned char* Km = lds; const LAS unsigned char* VT = lds + 69632;
    const size_t row = (size_t)tile * 128 + 16 * wid + fr;
    bf16x8 qf[4];
#pragma unroll
    for (int ks = 0; ks < 4; ++ks) qf[ks] = *(const bf16x8*)(H + row * INW + C_QM + h * 128 + 8 * fq + 32 * ks);
    f32x4 s[16];
#pragma unroll
    for (int t = 0; t < 16; ++t) { f32x4 acc = {0.f, 0.f, 0.f, 0.f};
#pragma unroll
        for (int ks = 0; ks < 4; ++ks) { const bf16x8 kf = *(const LAS bf16x8*)(Km + (16 * t + fr) * 272 + (8 * fq + 32 * ks) * 2); acc = __builtin_amdgcn_mfma_f32_16x16x32_bf16(kf, qf[ks], acc, 0, 0, 0); }
        s[t] = acc; }
    float mx = -1e30f;
#pragma unroll
    for (int t = 0; t < 16; ++t)
#pragma unroll
        for (int i = 0; i < 4; ++i) mx = fmaxf(mx, s[t][i]);
    mx = fmaxf(mx, __shfl_xor(mx, 16)); mx = fmaxf(mx, __shfl_xor(mx, 32));
    const float cs = 0.08838834764831845f * 1.44269504f; float sum = 0.f;
#pragma unroll
    for (int t = 0; t < 16; ++t)
#pragma unroll
        for (int i = 0; i < 4; ++i) { const float p = __builtin_amdgcn_exp2f((s[t][i] - mx) * cs); s[t][i] = p; sum += p; }
    sum += __shfl_xor(sum, 16); sum += __shfl_xor(sum, 32);
    f32x4 o[8];
#pragma unroll
    for (int eb = 0; eb < 8; ++eb) o[eb] = (f32x4){0.f, 0.f, 0.f, 0.f};
#pragma unroll
    for (int c = 0; c < 8; ++c) { const int t0 = 2 * c, t1 = t0 + 1;
        u32x4 pw; pw.x = cvt_pk_bf16(s[t0][0], s[t0][1]); pw.y = cvt_pk_bf16(s[t0][2], s[t0][3]); pw.z = cvt_pk_bf16(s[t1][0], s[t1][1]); pw.w = cvt_pk_bf16(s[t1][2], s[t1][3]);
        const bf16x8 pf = __builtin_bit_cast(bf16x8, pw);
#pragma unroll
        for (int eb = 0; eb < 8; ++eb) { const LAS unsigned char* vp = VT + (16 * eb + fr) * 544 + (16 * t0 + 4 * fq) * 2;
            const u32x2 lo = *(const LAS u32x2*)vp, hi = *(const LAS u32x2*)(vp + 32);
            const u32x4 vw = {lo.x, lo.y, hi.x, hi.y};
            o[eb] = __builtin_amdgcn_mfma_f32_16x16x32_bf16(__builtin_bit_cast(bf16x8, vw), pf, o[eb], 0, 0, 0); } }
    const float inv = 1.0f / sum;
    bf16_t* op = OM + row * 512 + h * 128 + 4 * fq;
#pragma unroll
    for (int eb = 0; eb < 8; ++eb) { u32x2 w; w.x = cvt_pk_bf16(o[eb][0] * inv, o[eb][1] * inv); w.y = cvt_pk_bf16(o[eb][2] * inv, o[eb][3] * inv); *(u32x2*)(op + 16 * eb) = w; }
}
__device__ __forceinline__ void smem_wg(const Args& a, const bf16_t* H, bf16_t* OM, int item, LAS float* sm, int tid, int wid, int lane) {
    const int b = item >> 2, h = item & 3; const size_t row = SQ + b; const float* cm = a.in[6];
    LAS float* qs = sm; LAS float* wmaxs = sm + 128; LAS float* wsums = sm + 144; LAS float* part = sm + 256;
    if (tid < 128) qs[tid] = bf2f(H[row * INW + C_QM + h * 128 + tid]);
    __syncthreads();
    const int kl = lane >> 1, hf = lane & 1, key = wid * 32 + kl;
    const float* kp = cm + (((size_t)b * 256 + key) * 2 + 0) * 512 + h * 128 + hf * 64; float dot = 0.f;
#pragma unroll
    for (int e = 0; e < 64; e += 4) { const f32x4 k4 = *(const f32x4*)(kp + e); const f32x4 x4 = *(const LAS f32x4*)(qs + hf * 64 + e); dot += k4[0] * x4[0] + k4[1] * x4[1] + k4[2] * x4[2] + k4[3] * x4[3]; }
    dot += __shfl_xor(dot, 1);
    const float sc = dot * 0.08838834764831845f;
    const float wm = wave_max(sc); if (lane == 0) wmaxs[wid] = wm;
    __syncthreads();
    float mx = wmaxs[0];
#pragma unroll
    for (int w = 1; w < 8; ++w) mx = fmaxf(mx, wmaxs[w]);
    const float p = __expf(sc - mx); const float psum = wave_sum(p) * 0.5f;
    const int e32 = lane & 31, kq = lane >> 5; f32x4 acc = {0.f, 0.f, 0.f, 0.f};
#pragma unroll
    for (int j = 0; j < 16; ++j) { const int kloc = kq * 16 + j; const float pk = __shfl(p, 2 * kloc);
        const f32x4 v4 = *(const f32x4*)(cm + (((size_t)b * 256 + wid * 32 + kloc) * 2 + 1) * 512 + h * 128 + e32 * 4); acc = acc + v4 * pk; }
#pragma unroll
    for (int j = 0; j < 4; ++j) acc[j] += __shfl_xor(acc[j], 32);
    if (lane < 32) *(LAS f32x4*)(part + wid * 128 + e32 * 4) = acc;
    if (lane == 0) wsums[wid] = psum;
    __syncthreads();
    if (tid < 128) { float o = 0.f, sum = 0.f;
#pragma unroll
        for (int w = 0; w < 8; ++w) { o += part[w * 128 + tid]; sum += wsums[w]; }
        OM[row * 512 + h * 128 + tid] = f2bf(o / sum); }
    __syncthreads();
}

__device__ __forceinline__ void gmlp_item(const Args& a, const bf16_t* H, const float* vstat, const bf16_t* WSB, bf16_t* OB, int item, LAS unsigned char* lds, int tid, int wid, int lane) {
    const int fr = lane & 15, fq = lane >> 4, n = item >> 2, g = item & 3, t0 = n * 128;
    LAS unsigned char* VT = lds;
    LAS unsigned char* Wl = lds + 52224;
#pragma unroll
    for (int it = 0; it < 4; ++it) { const int p = tid + 512 * it, i = p >> 4, ch = p & 15;
        *(LAS u32x4*)(Wl + i * 272 + ch * 16) = *(const u32x4*)(WSB + (size_t)g * 16384 + i * 128 + ch * 8); }
    const float* lng = a.in[10]; const float* lnb = a.in[11];
#pragma unroll
    for (int it = 0; it < 6; ++it) { const int j = (it & 1) * 64 + lane, ch = wid + 8 * (it >> 1), c0 = g * 192 + ch * 8;
        const size_t row = (size_t)t0 + j;
        const u32x4 v = *(const u32x4*)(H + row * INW + C_VB + c0);
        float s1 = 0.f, s2 = 0.f;
#pragma unroll
        for (int q = 0; q < 6; ++q) { const f32x4 pv = *(const f32x4*)(vstat + row * 24 + q * 4); s1 += pv[0] + pv[2]; s2 += pv[1] + pv[3]; }
        const float mean = s1 * (1.0f / 768.0f), var = s2 * (1.0f / 768.0f) - mean * mean, rstd = __builtin_amdgcn_rsqf(var + LN_EPS);
        const f32x4 g0 = *(const f32x4*)(lng + c0), g1 = *(const f32x4*)(lng + c0 + 4), b0 = *(const f32x4*)(lnb + c0), b1 = *(const f32x4*)(lnb + c0 + 4);
        LAS unsigned short* vp = (LAS unsigned short*)(VT + (ch * 8) * 272 + j * 2);
        vp[0 * 136] = f2bf((bflo(v.x) - mean) * rstd * g0[0] + b0[0]); vp[1 * 136] = f2bf((bfhi(v.x) - mean) * rstd * g0[1] + b0[1]);
        vp[2 * 136] = f2bf((bflo(v.y) - mean) * rstd * g0[2] + b0[2]); vp[3 * 136] = f2bf((bfhi(v.y) - mean) * rstd * g0[3] + b0[3]);
        vp[4 * 136] = f2bf((bflo(v.z) - mean) * rstd * g1[0] + b1[0]); vp[5 * 136] = f2bf((bfhi(v.z) - mean) * rstd * g1[1] + b1[1]);
        vp[6 * 136] = f2bf((bflo(v.w) - mean) * rstd * g1[2] + b1[2]); vp[7 * 136] = f2bf((bfhi(v.w) - mean) * rstd * g1[3] + b1[3]); }
    __syncthreads();
    f32x4 acc[12];
#pragma unroll
    for (int cb = 0; cb < 12; ++cb) acc[cb] = (f32x4){0.f, 0.f, 0.f, 0.f};
    const int nks = (wid >> 1) + 1;
    for (int ks = 0; ks < nks; ++ks) { const bf16x8 wf = *(const LAS bf16x8*)(Wl + (16 * wid + fr) * 272 + (8 * fq + 32 * ks) * 2);
#pragma unroll
        for (int cb = 0; cb < 12; ++cb) { const bf16x8 vf = *(const LAS bf16x8*)(VT + (16 * cb + fr) * 272 + (8 * fq + 32 * ks) * 2);
            acc[cb] = __builtin_amdgcn_mfma_f32_16x16x32_bf16(vf, wf, acc[cb], 0, 0, 0); } }
    const size_t row = (size_t)t0 + 16 * wid + fr; const float bsv = a.in[13][g * 128 + 16 * wid + fr];
#pragma unroll
    for (int cb = 0; cb < 12; ++cb) { const int c = g * 192 + 16 * cb + 4 * fq;
        const u32x2 uw = *(const u32x2*)(H + row * INW + C_UB + c);
        u32x2 w; w.x = cvt_pk_bf16(bflo(uw.x) * (acc[cb][0] + bsv), bfhi(uw.x) * (acc[cb][1] + bsv)); w.y = cvt_pk_bf16(bflo(uw.y) * (acc[cb][2] + bsv), bfhi(uw.y) * (acc[cb][3] + bsv));
        *(u32x2*)(OB + row * 768 + c) = w; }
    __syncthreads();
}
__device__ __forceinline__ void sgmlp_item(const Args& a, const bf16_t* H, const float* vstat, bf16_t* OB, int b, int lane) {
    const size_t row = SQ + b; const float* lng = a.in[10]; const float* lnb = a.in[11]; const float* wsp = a.in[12]; const float* bsp = a.in[13];
    float s1 = 0.f, s2 = 0.f;
#pragma unroll
    for (int jj = 0; jj < 3; ++jj) { const u32x2 vw = *(const u32x2*)(H + row * INW + C_VB + 4 * lane + 256 * jj); const float x0 = bflo(vw.x), x1 = bfhi(vw.x), x2 = bflo(vw.y), x3 = bfhi(vw.y); s1 += (x0 + x1) + (x2 + x3); s2 += (x0 * x0 + x1 * x1) + (x2 * x2 + x3 * x3); }
    s1 = wave_sum(s1); s2 = wave_sum(s2);
    const float mean = s1 * (1.0f / 768.0f), var = s2 * (1.0f / 768.0f) - mean * mean, rstd = __builtin_amdgcn_rsqf(var + LN_EPS);
    float* gv = a.out + O_GV + (size_t)b * 768;
#pragma unroll
    for (int jj = 0; jj < 3; ++jj) { const int c = 4 * lane + 256 * jj;
        const u32x2 vw = *(const u32x2*)(H + row * INW + C_VB + c), uw = *(const u32x2*)(H + row * INW + C_UB + c);
        const f32x4 g4 = *(const f32x4*)(lng + c), b4 = *(const f32x4*)(lnb + c);
        f32x4 vn; vn[0] = (bflo(vw.x) - mean) * rstd * g4[0] + b4[0]; vn[1] = (bfhi(vw.x) - mean) * rstd * g4[1] + b4[1]; vn[2] = (bflo(vw.y) - mean) * rstd * g4[2] + b4[2]; vn[3] = (bfhi(vw.y) - mean) * rstd * g4[3] + b4[3];
        *(f32x4*)(gv + c) = vn;
        const int gg = c / 192; const float w00 = wsp[gg * 16384], b00 = bsp[gg * 128];
        u32x2 w; w.x = cvt_pk_bf16(bflo(uw.x) * (w00 * vn[0] + b00), bfhi(uw.x) * (w00 * vn[1] + b00)); w.y = cvt_pk_bf16(bflo(uw.y) * (w00 * vn[2] + b00), bfhi(uw.y) * (w00 * vn[3] + b00));
        *(u32x2*)(OB + row * 768 + c) = w; }
}

__device__ __forceinline__ void ln_row(const float* in, const float* gam, const float* bet, float* out32, bf16_t* out16, int lane) {
    f32x4 v[4]; float s = 0.f;
#pragma unroll
    for (int j = 0; j < 4; ++j) { v[j] = *(const f32x4*)(in + 4 * lane + 256 * j); s += (v[j][0] + v[j][1]) + (v[j][2] + v[j][3]); }
    const float mean = wave_sum(s) * (1.0f / 1024.0f); float s2 = 0.f;
#pragma unroll
    for (int j = 0; j < 4; ++j) { v[j] = v[j] - mean; s2 += (v[j][0] * v[j][0] + v[j][1] * v[j][1]) + (v[j][2] * v[j][2] + v[j][3] * v[j][3]); }
    const float rstd = __builtin_amdgcn_rsqf(wave_sum(s2) * (1.0f / 1024.0f) + LN_EPS);
#pragma unroll
    for (int j = 0; j < 4; ++j) { const f32x4 g4 = *(const f32x4*)(gam + 4 * lane + 256 * j), b4 = *(const f32x4*)(bet + 4 * lane + 256 * j);
        const f32x4 y = v[j] * rstd * g4 + b4;
        *(f32x4*)(out32 + 4 * lane + 256 * j) = y;
        if (out16) { u32x2 w; w.x = cvt_pk_bf16(y[0], y[1]); w.y = cvt_pk_bf16(y[2], y[3]); *(u32x2*)(out16 + 4 * lane + 256 * j) = w; } }
}

#define XB_TMO      128
#define XB_XCNT(j)  (256  + 64 * (j))
#define XB_XSUB(j)  (1280 + 64 * (j))
#define XB_XGEN(j)  (2304 + 64 * (j))
#define XB_TOP      3328
#define XB_TOPGEN   3392
#define XCD_BAR_WORDS 3456
#define XB_SPIN_CAP (1u << 18)

__device__ __forceinline__ unsigned xb_ld(unsigned* p)              { return __hip_atomic_load(p, __ATOMIC_RELAXED, __HIP_MEMORY_SCOPE_AGENT); }
__device__ __forceinline__ unsigned xb_add(unsigned* p, unsigned v) { return __hip_atomic_fetch_add(p, v, __ATOMIC_RELAXED, __HIP_MEMORY_SCOPE_AGENT); }
__device__ __forceinline__ unsigned xb_xcc_id() { return (unsigned)__builtin_amdgcn_s_getreg((3 << 11) | 20) & 0xFu; }
#define XB_SPIN(cond, bar) do { unsigned _sp = 0; while (cond) { __builtin_amdgcn_s_sleep(1); \
    if ((++_sp & 255u) == 0u) { if (xb_ld(&(bar)[XB_TMO])) break; if (_sp > XB_SPIN_CAP) { atomicAdd(&(bar)[XB_TMO], 1u); break; } } } } while (0)

struct XcdBarrier {
    unsigned* bar; unsigned x;
    volatile LAS unsigned* st;
};

__device__ __forceinline__ XcdBarrier xcd_barrier_post(unsigned* bar, volatile LAS unsigned* st) {
    XcdBarrier b; b.bar = bar; b.x = xb_xcc_id(); b.st = st;
    if (threadIdx.x == 0) (void)xb_add(&bar[XB_XCNT(b.x)], 1u);
    return b;
}
__device__ __forceinline__ void xcd_barrier_complete(unsigned* bar, unsigned x, unsigned& nloc, unsigned& nx) {
    const unsigned G = gridDim.x * gridDim.y * gridDim.z;
    unsigned sum, cnt, mine, sp = 0u;
    for (;;) {
        sum = 0u; cnt = 0u; mine = 0u;
#pragma unroll
        for (unsigned j = 0; j < 16; ++j) { const unsigned c = xb_ld(&bar[XB_XCNT(j)]); sum += c; cnt += (c > 0u) ? 1u : 0u; mine = (j == x) ? c : mine; }
        if (sum == G) break;
        __builtin_amdgcn_s_sleep(1);
        if ((++sp & 255u) == 0u) { if (xb_ld(&bar[XB_TMO])) break; if (sp > XB_SPIN_CAP) { atomicAdd(&bar[XB_TMO], 1u); break; } }
    }
    nloc = mine > 0u ? mine : 1u; nx = cnt > 0u ? cnt : 1u;
}

__device__ __forceinline__ void xcd_barrier(const XcdBarrier& b) {
    asm volatile("s_waitcnt vmcnt(0)" ::: "memory");
    __syncthreads();
    if (threadIdx.x == 0) {
        unsigned* bar = b.bar;
        __builtin_amdgcn_s_waitcnt(0);
        unsigned nloc = b.st[0], nx = b.st[1];
        if (nloc == 0u) { xcd_barrier_complete(bar, b.x, nloc, nx); b.st[0] = nloc; b.st[1] = nx; }
        const unsigned old = xb_add(&bar[XB_XSUB(b.x)], 1u);
        const unsigned gen = old / nloc;
        if (old + 1u == (gen + 1u) * nloc) {
            __builtin_amdgcn_fence(__ATOMIC_RELEASE, "agent");
            asm volatile("s_waitcnt vmcnt(0)" ::: "memory");
            const unsigned og = xb_add(&bar[XB_TOP], 1u);
            const unsigned tg = og / nx;
            if (og + 1u == (tg + 1u) * nx) xb_add(&bar[XB_TOPGEN], 1u);
            else XB_SPIN(xb_ld(&bar[XB_TOPGEN]) == tg, bar);
            __builtin_amdgcn_fence(__ATOMIC_ACQUIRE, "agent");
            xb_add(&bar[XB_XGEN(b.x)], 1u);
            asm volatile("s_waitcnt vmcnt(0)" ::: "memory");
        } else {
            XB_SPIN(xb_ld(&bar[XB_XGEN(b.x)]) == gen, bar);
            __builtin_amdgcn_fence(__ATOMIC_ACQUIRE, "agent");
            asm volatile("s_waitcnt vmcnt(0)" ::: "memory");
        }
    }
    __syncthreads();
}

__global__ void __launch_bounds__(512, 2) mega(Args a) {
    extern __shared__ __attribute__((aligned(16))) unsigned char lds_raw[];
    cg::grid_group grid = cg::this_grid();
    LAS unsigned char* lds = (LAS unsigned char*)lds_raw;
    const int tid = threadIdx.x, lane = tid & 63, wid = __builtin_amdgcn_readfirstlane(tid >> 6);
    const int bx = blockIdx.x, G = gridDim.x;
    const size_t gt = (size_t)bx * 512 + tid, GT = (size_t)G * 512;
    const int gw = bx * 8 + wid, NGW = G * 8;
    unsigned char* ws = a.ws;
    float* VSTAT = (float*)(ws + WS_VSTAT);
    bf16_t* WinT = (bf16_t*)(ws + WS_WIN); bf16_t* WmemT = (bf16_t*)(ws + WS_WMEM); bf16_t* WbaT = (bf16_t*)(ws + WS_WBA); bf16_t* WbbT = (bf16_t*)(ws + WS_WBB);
    bf16_t* WbmT = (bf16_t*)(ws + WS_WBM); bf16_t* WoutT = (bf16_t*)(ws + WS_WOUT); bf16_t* WupT = (bf16_t*)(ws + WS_WUP); bf16_t* WdownT = (bf16_t*)(ws + WS_WDOWN);
    bf16_t* WSB = (bf16_t*)(ws + WS_WSB); bf16_t* MEMB = (bf16_t*)(ws + WS_MEMB); bf16_t* MKV = (bf16_t*)(ws + WS_MKV);
    bf16_t* XB = (bf16_t*)(ws + WS_XB); bf16_t* H = (bf16_t*)(ws + WS_H); bf16_t* OG = (bf16_t*)(ws + WS_OG); float* LSE = (float*)(ws + WS_LSE);
    bf16_t* OA = (bf16_t*)(ws + WS_OA); bf16_t* OB = (bf16_t*)(ws + WS_OB); bf16_t* OM = (bf16_t*)(ws + WS_OM); bf16_t* MIX = (bf16_t*)(ws + WS_MIX);
    float* Z1 = (float*)(ws + WS_Z1); bf16_t* X1B = (bf16_t*)(ws + WS_X1B); bf16_t* U = (bf16_t*)(ws + WS_U); bf16_t* HH = (bf16_t*)(ws + WS_HH);
    LAS float* red = (LAS float*)lds;

    unsigned* barw = (unsigned*)(ws + WS_BAR);
    volatile LAS unsigned* bst = (volatile LAS unsigned*)(lds + LDS_BYTES - 16);
    if (tid < 4) bst[tid] = 0u;
    if (bx == 0) for (int i = tid; i < XCD_BAR_WORDS; i += 512) barw[i] = 0u;
    __syncthreads();
    p0_prologue(a, lds, tid, wid, lane);
    grid.sync();
    const XcdBarrier xbar = xcd_barrier_post(barw, bst);

    for (int it = bx; it < INW / 16; it += G) { const int n0 = it * 16;
        const float v = sgemm_item(XB + (size_t)SQ * DM, WinT, DM, n0, red, tid, wid, lane);
        const int r = tid >> 4, col = n0 + (tid & 15); const size_t row = SQ + r; float o = v;
        if (col >= C_UB && col < C_QM) o = gelu_t(v);
        H[row * INW + col] = f2bf(o); }
    { pg8::Gemm g{XB, WinT, SQ, INW, DM}; pg8::StaticOrder S; S.init(SQ, INW, G, bx);
      pg8::EpiIn E{H, INW, VSTAT};
      pg8::gemm_phase<pg8::EpiIn, pg8::StaticOrder, true, true>(lds, g, S, E); }
    { pg8::Gemm g{MEMB, WmemT, NMEM, 1024, DM}; pg8::StaticOrder S; S.init(NMEM, 1024, G, (bx + 128) % G);
      pg8::EpiMem E{a.out + O_MEMP, MKV};
      pg8::gemm_phase<pg8::EpiMem, pg8::StaticOrder, true, true>(lds, g, S, E); }
    xcd_barrier(xbar);

    for (int T = bx; T < 1536; T += G) attn_tile(H, OG, LSE, T, lds, tid, wid, lane);
    if (bx < 128) sattn_wg(a, H, OA, bx, (LAS float*)lds, tid, wid, lane); else if (bx < 256) smem_wg(a, H, OM, bx - 128, (LAS float*)lds, tid, wid, lane);
    {
        const size_t oP[3] = {O_W128P, O_W512P, O_W2048P}, oS[3] = {O_W128S, O_W512S, O_W2048S};
#pragma unroll
        for (int g = 0; g < 3; ++g) { const int keep = 128 << (2 * g); float* op = a.out + oP[g]; float* os = a.out + oS[g];
            for (size_t i = gt; i < (size_t)keep * 512; i += GT) { const int p = (int)(i >> 9), kv = (int)(i >> 8) & 1, he = (int)i & 255;
                op[i] = bf2f(H[(size_t)(SQ - keep + p) * INW + (kv ? C_VA : C_KA) + g * 256 + he]); }
            for (size_t i = gt; i < (size_t)NSMP * 512; i += GT) { const int b = (int)(i >> 9), kv = (int)(i >> 8) & 1, he = (int)i & 255;
                os[i] = bf2f(H[(size_t)(SQ + b) * INW + (kv ? C_VA : C_KA) + g * 256 + he]); } }
    }
    xcd_barrier(xbar);

    for (size_t i = gt; i < (size_t)SQ * 32; i += GT) { const size_t tok = i >> 5; const int h = (int)(i >> 3) & 3, e8 = (int)i & 7;
        const float l0 = LSE[(0 * (size_t)MV + tok) * 4 + h], l1 = LSE[(1 * (size_t)MV + tok) * 4 + h], l2 = LSE[(2 * (size_t)MV + tok) * 4 + h];
        const float m = fmaxf(l0, fmaxf(l1, l2)); float w0 = __expf(l0 - m), w1 = __expf(l1 - m), w2 = __expf(l2 - m); const float inv = 1.0f / (w0 + w1 + w2); w0 *= inv; w1 *= inv; w2 *= inv;
        const u32x4 x0 = *(const u32x4*)(OG + (0 * (size_t)MV + tok) * 256 + h * 64 + e8 * 8), x1 = *(const u32x4*)(OG + (1 * (size_t)MV + tok) * 256 + h * 64 + e8 * 8), x2 = *(const u32x4*)(OG + (2 * (size_t)MV + tok) * 256 + h * 64 + e8 * 8);
        u32x4 w;
        w.x = cvt_pk_bf16(w0 * bflo(x0.x) + w1 * bflo(x1.x) + w2 * bflo(x2.x), w0 * bfhi(x0.x) + w1 * bfhi(x1.x) + w2 * bfhi(x2.x));
        w.y = cvt_pk_bf16(w0 * bflo(x0.y) + w1 * bflo(x1.y) + w2 * bflo(x2.y), w0 * bfhi(x0.y) + w1 * bfhi(x1.y) + w2 * bfhi(x2.y));
        w.z = cvt_pk_bf16(w0 * bflo(x0.z) + w1 * bflo(x1.z) + w2 * bflo(x2.z), w0 * bfhi(x0.z) + w1 * bfhi(x1.z) + w2 * bfhi(x2.z));
        w.w = cvt_pk_bf16(w0 * bflo(x0.w) + w1 * bflo(x1.w) + w2 * bflo(x2.w), w0 * bfhi(x0.w) + w1 * bfhi(x1.w) + w2 * bfhi(x2.w));
        *(u32x4*)(OA + tok * 256 + h * 64 + e8 * 8) = w; }
    {
        const int h = bx & 3; mem_load_kv(MKV, h, lds, tid, wid, lane);
        for (int tile = bx >> 2; tile < SQ / 128; tile += (G >> 2)) mem_tile(H, OM, h, tile, lds, wid, lane);
        __syncthreads(); }
    for (int it = bx; it < 512; it += G) gmlp_item(a, H, VSTAT, WSB, OB, it, lds, tid, wid, lane);
    if (wid == 2 && bx >= 128 && bx < 160) sgmlp_item(a, H, VSTAT, OB, bx - 128, lane);
    xcd_barrier(xbar);

    for (int it = bx; it < DM / 16; it += G) { const int n0 = it * 16; const int r = tid >> 4, col = n0 + (tid & 15); const size_t row = SQ + r;
        const float va = sgemm_item(OA + (size_t)SQ * 256, WbaT, 256, n0, red, tid, wid, lane);
        const float vb = sgemm_item(OB + (size_t)SQ * 768, WbbT, 768, n0, red, tid, wid, lane);
        const float vm = sgemm_item(OM + (size_t)SQ * 512, WbmT, 512, n0, red, tid, wid, lane);
        const float* bg = a.in[9]; const bf16_t* hg = H + row * INW + C_GT + col;
        const float o = sigm(bf2f(hg[0]) + bg[col]) * va + sigm(bf2f(hg[1024]) + bg[1024 + col]) * vb + sigm(bf2f(hg[2048]) + bg[2048 + col]) * vm;
        MIX[row * 1024 + col] = f2bf(o); }
    { pg8::StaticOrder S; S.init(SQ, DM, G, bx);
      { pg8::Gemm g{OA, WbaT, SQ, DM, 256}; pg8::EpiGate E{H + C_GT, INW, a.in[9], MIX, 1}; pg8::gemm_phase<pg8::EpiGate, pg8::StaticOrder, true, true>(lds, g, S, E); }
      { pg8::Gemm g{OB, WbbT, SQ, DM, 768}; pg8::EpiGate E{H + C_GT + 1024, INW, a.in[9] + 1024, MIX, 0}; pg8::gemm_phase<pg8::EpiGate, pg8::StaticOrder, true, true>(lds, g, S, E); }
      { pg8::Gemm g{OM, WbmT, SQ, DM, 512}; pg8::EpiGate E{H + C_GT + 2048, INW, a.in[9] + 2048, MIX, 0}; pg8::gemm_phase<pg8::EpiGate, pg8::StaticOrder, true, true>(lds, g, S, E); } }
    xcd_barrier(xbar);

    for (int it = bx; it < DM / 16; it += G) { const int n0 = it * 16; const int r = tid >> 4, col = n0 + (tid & 15);
        const float v = sgemm_item(MIX + (size_t)SQ * DM, WoutT, DM, n0, red, tid, wid, lane);
        Z1[(size_t)(SQ + r) * DM + col] = ALPHA * a.in[1][r * DM + col] + v; }
    { pg8::Gemm g{MIX, WoutT, SQ, DM, DM}; pg8::StaticOrder S; S.init(SQ, DM, G, bx);
      pg8::EpiRes E{a.in[0], Z1, ALPHA};
      pg8::gemm_phase<pg8::EpiRes, pg8::StaticOrder, true, true>(lds, g, S, E); }
    xcd_barrier(xbar);

    for (int row = gw; row < MV; row += NGW) ln_row(Z1 + (size_t)row * DM, a.in[19], a.in[20], Z1 + (size_t)row * DM, X1B + (size_t)row * DM, lane);
    xcd_barrier(xbar);

    { const float* cw = a.in[22]; const float* cb = a.in[23]; const float* st = a.in[7];
      for (int it = bx; it < DFF / 16; it += G) { const int c0 = it * 16, n0a = 256 * (c0 >> 7) + (c0 & 127); const int r = tid >> 4, ch = c0 + (tid & 15);
        const float av = sgemm_item(X1B + (size_t)SQ * DM, WupT, DM, n0a, red, tid, wid, lane);
        const float vv = sgemm_item(X1B + (size_t)SQ * DM, WupT, DM, n0a + 128, red, tid, wid, lane);
        const float s0 = st[((size_t)r * 2 + 0) * DFF + ch], s1 = st[((size_t)r * 2 + 1) * DFF + ch];
        const float cv = cb[ch] + cw[ch] * s0 + cw[DFF + ch] * s1 + cw[2 * DFF + ch] * av;
        HH[(size_t)(SQ + r) * DFF + ch] = f2bf(gelu_t(cv) * vv);
        a.out[O_CONVS + ((size_t)r * 2 + 0) * DFF + ch] = s1; a.out[O_CONVS + ((size_t)r * 2 + 1) * DFF + ch] = av; }
      pg8::Gemm g{X1B - 2 * DM, WupT, 65 * 256, 2 * DFF, DM, (size_t)254 * DM * 2}; pg8::StaticOrder S; S.init(65 * 256, 2 * DFF, G, bx);
      pg8::EpiConv E{HH, cw, cb, a.out + O_CONVP, (LAS float*)(lds + 131072)};
      pg8::gemm_phase<pg8::EpiConv, pg8::StaticOrder, true, true>(lds, g, S, E); }
    xcd_barrier(xbar);

    for (int it = bx; it < DM / 16; it += G) { const int n0 = it * 16; const int r = tid >> 4, col = n0 + (tid & 15);
        const float v = sgemm_item(HH + (size_t)SQ * DFF, WdownT, DFF, n0, red, tid, wid, lane);
        float* zp = Z1 + (size_t)(SQ + r) * DM + col; *zp = ALPHA * (*zp) + v; }
    { pg8::Gemm g{HH, WdownT, SQ, DM, DFF}; pg8::StaticOrder S; S.init(SQ, DM, G, bx);
      pg8::EpiRes E{Z1, Z1, ALPHA};
      pg8::gemm_phase<pg8::EpiRes, pg8::StaticOrder, true, true>(lds, g, S, E); }
    xcd_barrier(xbar);

    for (int row = gw; row < MV; row += NGW) ln_row(Z1 + (size_t)row * DM, a.in[25], a.in[26], a.out + (row < SQ ? O_YP + (size_t)row * DM : O_YS + (size_t)(row - SQ) * DM), nullptr, lane);
}

extern "C" void kernel_launch(void* const* d_in, const int* in_sizes, int n_in, void* d_out, int out_size, void* d_ws, size_t ws_size, hipStream_t stream) {
    static int grid = 0;
    if (grid == 0) {
        if (n_in != 27 || (size_t)out_size != O_END || ws_size < WS_END || in_sizes[0] != SQ * DM) { fprintf(stderr, "kernel_launch: unexpected shapes: n_in %d out %d ws %zu\n", n_in, out_size, ws_size); grid = -1; return; }
        int dev = 0, cus = 0, per_cu = 0;
        if (hipGetDevice(&dev) != hipSuccess || hipDeviceGetAttribute(&cus, hipDeviceAttributeMultiprocessorCount, dev) != hipSuccess) { grid = -1; return; }
        if (hipFuncSetAttribute((const void*)mega, hipFuncAttributeMaxDynamicSharedMemorySize, LDS_BYTES) != hipSuccess) { fprintf(stderr, "kernel_launch: hipFuncSetAttribute failed\n"); grid = -1; return; }
        if (hipOccupancyMaxActiveBlocksPerMultiprocessor(&per_cu, (const void*)mega, 512, LDS_BYTES) != hipSuccess || per_cu < 1) { fprintf(stderr, "kernel_launch: occupancy query reports %d blocks per CU\n", per_cu); grid = -1; return; }
        grid = cus;
        if (grid % 4 != 0) grid -= grid % 4;
    }
    if (grid <= 0) return;
    Args a{};
    for (int i = 0; i < 27; ++i) a.in[i] = (const float*)d_in[i];
    a.out = (float*)d_out; a.ws = (unsigned char*)d_ws;
    void* args[] = {&a};
    hipError_t e = hipLaunchCooperativeKernel((const void*)mega, dim3(grid), dim3(512), args, LDS_BYTES, stream);
    if (e != hipSuccess) fprintf(stderr, "kernel_launch: cooperative launch failed: %s (grid %d)\n", hipGetErrorString(e), grid);
}
```
